# Optimizing an MI355X kernel written in HIP

```python
import jax, jax.numpy as jnp
from jax import lax
import numpy as np

D_MODEL = 1024
BATCH = 16
SEQ = 256
DEPTH = 2
DEC_BATCH = 2
DEC_SEQ = 4096
PAST_LEN = 256

GRID_W = 64
POS_BASE = 10000.0
MIX_W = 256
N_GROUPS = 4
GROUP_W = MIX_W // N_GROUPS
POOL_WINDOWS = (2, 4, 8, 16)
RWKV_HEADS = 4
RWKV_HEAD = MIX_W // RWKV_HEADS
RWKV_W_RANK = 64
RWKV_A_RANK = 32
RWKV_G_RANK = 64
RWKV_DECAY_SCALE = 0.606531
RWKV_GN_EPS = 64e-5
GLA_HEADS = 4
GLA_DK = 32
GLA_DV = MIX_W // GLA_HEADS
GLA_RANK = 16
GLA_CHUNK = 64
GLA_GATE_NORM = 16.0
N_BRANCH = 4
D_FF = 4 * D_MODEL
EPS = 1e-6
IN_SIZES = (MIX_W, MIX_W, 3 * MIX_W, 2 * RWKV_W_RANK, 2 * RWKV_A_RANK, RWKV_G_RANK,
            GLA_HEADS * GLA_DK, GLA_HEADS * GLA_DK, GLA_HEADS * GLA_DV, GLA_HEADS * GLA_DV,
            2 * GLA_RANK, N_BRANCH * D_MODEL)
P_IN = sum(IN_SIZES)

kernel_name = 'hybrid_pool_fourier_rwkv7_gla_diffusion_step'

F32 = jnp.float32


def _rmsnorm(x, g):
    xf = x.astype(F32)
    return xf * lax.rsqrt(jnp.mean(xf * xf, axis=-1, keepdims=True) + EPS) * g.astype(F32)


def _split_cols(u, sizes):
    out, start = [], 0
    for s in sizes:
        out.append(u[..., start:start + s])
        start += s
    return out


def _pos_embed_2d(n_tok, d):
    rows = n_tok // GRID_W
    rr, cc = jnp.meshgrid(jnp.arange(rows, dtype=F32), jnp.arange(GRID_W, dtype=F32), indexing='ij')
    rr = rr.reshape(-1)
    cc = cc.reshape(-1)
    quarter = d // 4
    omega = 1.0 / (POS_BASE ** (jnp.arange(quarter, dtype=F32) / quarter))
    ar = rr[:, None] * omega
    ac = cc[:, None] * omega
    return jnp.concatenate([jnp.sin(ar), jnp.cos(ar), jnp.sin(ac), jnp.cos(ac)], axis=-1)


def _pool_mixer(z, w, scale):
    b_, L, _ = z.shape
    csum = jnp.concatenate([jnp.zeros((b_, 1, MIX_W), F32), jnp.cumsum(z, axis=1)], axis=1)
    t = jnp.arange(L)
    parts = []
    for gi, win in enumerate(POOL_WINDOWS):
        sl = slice(gi * GROUP_W, (gi + 1) * GROUP_W)
        lo = jnp.clip(t - win // 2, 0, L - 1)
        hi = jnp.clip(t + (win - win // 2) - 1, 0, L - 1)
        s = jnp.take(csum[..., sl], hi + 1, axis=1) - jnp.take(csum[..., sl], lo, axis=1)
        cnt = (hi - lo + 1).astype(F32)[None, :, None]
        parts.append(s / cnt - z[..., sl])
    pooled = jnp.stack(parts, axis=2)
    y = jnp.einsum('blgc,gcd->blgd', pooled, w)
    return y.reshape(b_, L, MIX_W) * scale


def _fourier_mixer(z):
    b_, L, _ = z.shape
    zg = z.astype(F32).reshape(b_, L, N_GROUPS, GROUP_W)
    f = jnp.fft.fft2(zg, axes=(1, 3), norm='ortho')
    return jnp.real(f).astype(F32).reshape(b_, L, MIX_W)


def _token_shift(z):
    zp = jnp.pad(z, ((0, 0), (1, 1), (0, 0)))
    return 0.5 * (zp[:, :-2] + zp[:, 2:])


def _rwkv_scan(r, k, v, w, kk, a, s0, reverse):
    def step(S, inp):
        r_t, k_t, v_t, w_t, kk_t, a_t = inp
        sa = jnp.einsum('bhvk,bhk->bhv', S, -kk_t)
        S = S * w_t[:, :, None, :] + sa[..., None] * (kk_t * a_t)[:, :, None, :] + v_t[..., None] * k_t[:, :, None, :]
        return S, jnp.einsum('bhvk,bhk->bhv', S, r_t)
    xs = tuple(jnp.swapaxes(t, 0, 1) for t in (r, k, v, w, kk, a))
    s_fin, o = lax.scan(step, s0, xs, reverse=reverse)
    return jnp.swapaxes(o, 0, 1), s_fin


def _gla_chunked(q, k, v, log_a, s0):
    b_, L, H, _ = q.shape
    dv = v.shape[-1]
    n = L // GLA_CHUNK

    def chunks(t):
        return t.reshape(b_, n, GLA_CHUNK, H, t.shape[-1]).transpose(1, 0, 3, 2, 4)

    causal = jnp.tril(jnp.ones((GLA_CHUNK, GLA_CHUNK), dtype=bool))[None, None, :, :, None]

    def step(S, inp):
        qc, kc, vc, gc = inp
        bcum = jnp.cumsum(gc, axis=2)
        diff = bcum[:, :, :, None, :] - bcum[:, :, None, :, :]
        decay = jnp.exp(jnp.where(causal, diff, -jnp.inf))
        att = jnp.einsum('bhtd,bhsd,bhtsd->bhts', qc, kc, decay)
        o = jnp.einsum('bhts,bhse->bhte', att, vc) + jnp.einsum('bhtd,bhde->bhte', qc * jnp.exp(bcum), S)
        b_last = bcum[:, :, -1:, :]
        S = jnp.exp(b_last[:, :, 0, :])[..., None] * S + jnp.einsum('bhsd,bhse->bhde', kc * jnp.exp(b_last - bcum), vc)
        return S, o

    s_fin, o = lax.scan(step, s0, (chunks(q), chunks(k), chunks(v), chunks(log_a)))
    return o.transpose(1, 0, 3, 2, 4).reshape(b_, L, H, dv), s_fin


def _head_groupnorm(o):
    mu = jnp.mean(o, axis=-1, keepdims=True)
    var = jnp.mean(jnp.square(o - mu), axis=-1, keepdims=True)
    return (o - mu) * lax.rsqrt(var + RWKV_GN_EPS)


def _mixer_block(h, p, s_rwkv0, s_gla0):
    b_, L, _ = h.shape
    u = jnp.einsum('bld,dp->blp', h, p['w_in']).astype(F32)
    (z_pool, z_four, z_rkv, c_w, c_a, c_g, gq, gk, gv, g_out, c_al, m_log) = _split_cols(u, IN_SIZES)

    y_a = _pool_mixer(z_pool, p['pool_w'], p['pool_scale'])

    y_b = _fourier_mixer(z_four)

    hn = (b_, L, RWKV_HEADS, RWKV_HEAD)
    z_rkv = z_rkv + p['rwkv_mu'] * (_token_shift(z_rkv) - z_rkv)
    r = z_rkv[..., :MIX_W].reshape(hn)
    k = z_rkv[..., MIX_W:2 * MIX_W].reshape(hn)
    v = z_rkv[..., 2 * MIX_W:].reshape(hn)
    kk = k * p['rwkv_kk'].reshape(RWKV_HEADS, RWKV_HEAD)
    kk = kk * lax.rsqrt(jnp.sum(kk * kk, axis=-1, keepdims=True) + EPS)
    w_log = p['rwkv_w0'] + jnp.einsum('bldr,drc->bldc', jnp.tanh(c_w.reshape(b_, L, 2, RWKV_W_RANK)), p['rwkv_bw'])
    decay = jnp.exp(-RWKV_DECAY_SCALE * jax.nn.sigmoid(w_log)).reshape(b_, L, 2, RWKV_HEADS, RWKV_HEAD)
    iclr = jax.nn.sigmoid(p['rwkv_a0'] + jnp.einsum('bldr,drc->bldc', c_a.reshape(b_, L, 2, RWKV_A_RANK), p['rwkv_ba']))
    iclr = iclr.reshape(b_, L, 2, RWKV_HEADS, RWKV_HEAD)
    k_dir = k[:, :, None] * (1.0 + (iclr - 1.0) * p['rwkv_ka'].reshape(RWKV_HEADS, RWKV_HEAD))
    o_f, s_rf = _rwkv_scan(r, k_dir[:, :, 0], v, decay[:, :, 0], kk, iclr[:, :, 0], s_rwkv0[:, 0], False)
    o_bk, s_rb = _rwkv_scan(r, k_dir[:, :, 1], v, decay[:, :, 1], kk, iclr[:, :, 1], s_rwkv0[:, 1], True)
    o_c = _head_groupnorm(o_f + o_bk) * p['rwkv_gn'].reshape(RWKV_HEADS, RWKV_HEAD)
    bonus = jnp.sum(jnp.sum(r[:, :, None] * k_dir * p['rwkv_rk'], axis=-1, keepdims=True), axis=2)
    o_c = o_c + bonus * v
    gate_c = jnp.einsum('blr,rc->blc', jax.nn.sigmoid(c_g), p['rwkv_bg'])
    y_c = o_c.reshape(b_, L, MIX_W) * gate_c

    q = gq.reshape(b_, L, GLA_HEADS, GLA_DK) * (GLA_DK ** -0.5)
    kg = gk.reshape(b_, L, GLA_HEADS, GLA_DK)
    vg = gv.reshape(b_, L, GLA_HEADS, GLA_DV)
    log_a = jax.nn.log_sigmoid(jnp.einsum('bldr,drc->bldc', c_al.reshape(b_, L, 2, GLA_RANK), p['gla_ab'])
                               + p['gla_abias']) / GLA_GATE_NORM
    log_a = log_a.reshape(b_, L, 2, GLA_HEADS, GLA_DK)
    og_f, s_gf = _gla_chunked(q, kg, vg, log_a[:, :, 0], s_gla0[:, 0])
    og_rev, s_gb = _gla_chunked(jnp.flip(q, 1), jnp.flip(kg, 1), jnp.flip(vg, 1), jnp.flip(log_a[:, :, 1], 1), s_gla0[:, 1])
    og = og_f + jnp.flip(og_rev, 1)
    og = og * lax.rsqrt(jnp.mean(og * og, axis=-1, keepdims=True) + EPS) * p['gla_norm'].reshape(GLA_HEADS, GLA_DV)
    y_d = og.reshape(b_, L, MIX_W) * jax.nn.silu(g_out)

    ys = jnp.stack([y_a, y_b, y_c, y_d], axis=2)
    branch = jnp.einsum('blic,icd->blid', ys, p['w_branch'])
    gates = jax.nn.sigmoid(m_log.reshape(b_, L, N_BRANCH, D_MODEL))
    merged = jnp.sum(gates * branch, axis=2)
    out = jnp.einsum('bld,de->ble', merged, p['w_out'])
    return out, jnp.stack([s_rf, s_rb], axis=1), jnp.stack([s_gf, s_gb], axis=1)


def _layer(x, cond, p, s_rwkv0, s_gla0):
    mod = jnp.einsum('bd,de->be', jax.nn.silu(cond.astype(F32)), p['ada_w']) + p['ada_b']
    sh1, sc1, g1, sh2, sc2, g2 = jnp.split(mod[:, None, :].astype(F32), 6, axis=-1)
    h = _rmsnorm(x, p['norm1_g']) * (1.0 + sc1) + sh1
    mix, s_r, s_g = _mixer_block(h, p, s_rwkv0, s_gla0)
    xf = x.astype(F32) + g1 * mix
    h = _rmsnorm(xf, p['norm2_g']) * (1.0 + sc2) + sh2
    ff = jnp.einsum('blf,fd->bld', jnp.square(jax.nn.relu(jnp.einsum('bld,df->blf', h, p['mlp_w1']))), p['mlp_w2'])
    xf = xf + g2 * ff
    return xf.astype(x.dtype), s_r, s_g


def setup_inputs(seed: int = 0) -> dict:
    key = jax.random.key(seed)
    ks = jax.random.split(key, 40)

    def nrm(i, shape, scale):
        return jax.random.normal(ks[i], shape, F32) * scale

    def gain(i, shape):
        return 1.0 + 0.1 * jax.random.normal(ks[i], shape, F32)

    return {
        'x_prompt': nrm(0, (BATCH, SEQ, D_MODEL), 1.0),
        'x_sample': nrm(1, (DEC_BATCH, DEC_SEQ, D_MODEL), 1.0),
        'state_rwkv': nrm(2, (DEC_BATCH, DEPTH, 2, RWKV_HEADS, RWKV_HEAD, RWKV_HEAD), 0.5),
        'state_gla': nrm(3, (DEC_BATCH, DEPTH, 2, GLA_HEADS, GLA_DK, GLA_DV), 1.0),
        'c': nrm(4, (DEC_BATCH, D_MODEL), 1.0),
        'c_ctx': nrm(5, (D_MODEL,), 1.0),
        'ada_w': nrm(6, (DEPTH, D_MODEL, 6 * D_MODEL), 0.5 * D_MODEL ** -0.5),
        'ada_b': nrm(7, (DEPTH, 6 * D_MODEL), 0.02),
        'norm1_g': gain(8, (DEPTH, D_MODEL)),
        'norm2_g': gain(9, (DEPTH, D_MODEL)),
        'w_in': nrm(10, (DEPTH, D_MODEL, P_IN), D_MODEL ** -0.5),
        'pool_w': nrm(11, (DEPTH, N_GROUPS, GROUP_W, GROUP_W), GROUP_W ** -0.5),
        'pool_scale': gain(12, (DEPTH, MIX_W)),
        'rwkv_mu': jax.random.uniform(ks[13], (DEPTH, 3 * MIX_W), F32),
        'rwkv_w0': nrm(14, (DEPTH, 2, MIX_W), 0.5),
        'rwkv_bw': nrm(15, (DEPTH, 2, RWKV_W_RANK, MIX_W), 0.1 * RWKV_W_RANK ** -0.5),
        'rwkv_a0': nrm(16, (DEPTH, 2, MIX_W), 0.5),
        'rwkv_ba': nrm(17, (DEPTH, 2, RWKV_A_RANK, MIX_W), 0.5 * RWKV_A_RANK ** -0.5),
        'rwkv_kk': gain(18, (DEPTH, MIX_W)),
        'rwkv_ka': gain(19, (DEPTH, MIX_W)),
        'rwkv_bg': nrm(20, (DEPTH, RWKV_G_RANK, MIX_W), RWKV_G_RANK ** -0.5),
        'rwkv_rk': nrm(21, (DEPTH, RWKV_HEADS, RWKV_HEAD), 0.1),
        'rwkv_gn': gain(22, (DEPTH, MIX_W)),
        'gla_ab': nrm(23, (DEPTH, 2, GLA_RANK, GLA_HEADS * GLA_DK), 0.5 * GLA_RANK ** -0.5),
        'gla_abias': nrm(24, (DEPTH, 2, GLA_HEADS * GLA_DK), 0.5),
        'gla_norm': gain(25, (DEPTH, MIX_W)),
        'w_branch': nrm(26, (DEPTH, N_BRANCH, MIX_W, D_MODEL), MIX_W ** -0.5),
        'w_out': nrm(27, (DEPTH, D_MODEL, D_MODEL), D_MODEL ** -0.5),
        'mlp_w1': nrm(28, (DEPTH, D_MODEL, D_FF), D_MODEL ** -0.5),
        'mlp_w2': nrm(29, (DEPTH, D_FF, D_MODEL), D_FF ** -0.5),
        'final_g': gain(30, (D_MODEL,)),
    }


def reference(x_prompt, x_sample, state_rwkv, state_gla, c, c_ctx, ada_w, ada_b, norm1_g, norm2_g,
              w_in, pool_w, pool_scale, rwkv_mu, rwkv_w0, rwkv_bw, rwkv_a0, rwkv_ba, rwkv_kk, rwkv_ka,
              rwkv_bg, rwkv_rk, rwkv_gn, gla_ab, gla_abias, gla_norm, w_branch, w_out, mlp_w1, mlp_w2,
              final_g):
    def layer_params(l):
        return {'ada_w': ada_w[l], 'ada_b': ada_b[l], 'norm1_g': norm1_g[l], 'norm2_g': norm2_g[l],
                'w_in': w_in[l], 'pool_w': pool_w[l], 'pool_scale': pool_scale[l], 'rwkv_mu': rwkv_mu[l],
                'rwkv_w0': rwkv_w0[l], 'rwkv_bw': rwkv_bw[l], 'rwkv_a0': rwkv_a0[l], 'rwkv_ba': rwkv_ba[l],
                'rwkv_kk': rwkv_kk[l], 'rwkv_ka': rwkv_ka[l], 'rwkv_bg': rwkv_bg[l], 'rwkv_rk': rwkv_rk[l],
                'rwkv_gn': rwkv_gn[l], 'gla_ab': gla_ab[l], 'gla_abias': gla_abias[l], 'gla_norm': gla_norm[l],
                'w_branch': w_branch[l], 'w_out': w_out[l], 'mlp_w1': mlp_w1[l], 'mlp_w2': mlp_w2[l]}

    xp = x_prompt
    bp = x_prompt.shape[0]
    new_r, new_g = [], []
    for l in range(DEPTH):
        xp, s_r, s_g = _layer(xp, c_ctx[None, :], layer_params(l),
                              jnp.zeros((bp, 2, RWKV_HEADS, RWKV_HEAD, RWKV_HEAD), F32),
                              jnp.zeros((bp, 2, GLA_HEADS, GLA_DK, GLA_DV), F32))
        new_r.append(s_r)
        new_g.append(s_g)
    y_prompt = _rmsnorm(xp, final_g).astype(x_prompt.dtype)
    new_state_rwkv = jnp.stack(new_r, axis=1)
    new_state_gla = jnp.stack(new_g, axis=1)

    n_tok = x_sample.shape[1]
    xs = (x_sample.astype(F32) + _pos_embed_2d(n_tok, D_MODEL)[None]).astype(x_sample.dtype)
    for l in range(DEPTH):
        xs, _, _ = _layer(xs, c, layer_params(l), state_rwkv[:, l].astype(F32), state_gla[:, l].astype(F32))
    y_sample = _rmsnorm(xs, final_g).astype(x_sample.dtype)

    return (y_prompt, y_sample, new_state_rwkv, new_state_gla)
```

```cpp
#define TILE_STRIP 6
#include <hip/hip_runtime.h>
#include <hip/hip_cooperative_groups.h>
#include <cstdio>
#include <cstdint>
namespace cg = cooperative_groups;

typedef unsigned short bf16_t;
typedef short bf16x8 __attribute__((ext_vector_type(8)));
typedef float f32x4 __attribute__((ext_vector_type(4)));

#define NT 12288
#define DM 1024
#define NU 2176
#define NWIN 6784
#define DFF 4096
#define UP 0
#define UR 256
#define UK 512
#define UV 768
#define UCW 1024
#define UCA 1152
#define UCG 1216
#define UGQ 1280
#define UGK 1408
#define UGV 1536
#define UGO 1792
#define UCAL 2048

#define OFF_MOD 0ull
#define OFF_TAB 147456ull
#define OFF_WIN 155648ull
#define OFF_WB 14049280ull
#define OFF_WO 16146432ull
#define OFF_W1 18243584ull
#define OFF_W2 26632192ull
#define OFF_H 35020800ull
#define OFF_U 60186624ull
#define OFF_ZT 113664000ull
#define OFF_YS 126246912ull
#define OFF_ORW 151412736ull
#define OFF_M 163995648ull
#define WS_END 264658944ull
#define M_R 0ull
#define M_V 6291456ull
#define M_KK 12582912ull
#define M_KD 18874368ull
#define M_B 31457280ull
#define M_W 44040192ull
#define M_OG 69206016ull
#define M_GS 81788928ull

#define OUT_SR 12582912ull
#define OUT_SG 13631488ull

#define LDS_BYTES 74256
#define LDS_TAB 66048

struct Params {
  const float* in[31];
  float* out;
  unsigned char* ws_;
};
enum { I_XP = 0, I_XS, I_SRW, I_SGL, I_C, I_CCTX, I_ADAW, I_ADAB, I_N1G, I_N2G, I_WIN, I_POOLW, I_POOLS, I_MU, I_W0, I_BW,
       I_A0, I_BA, I_KKP, I_KA, I_BG, I_RK, I_GN, I_GAB, I_GABIAS, I_GNORM, I_WBR, I_WOUT, I_W1, I_W2, I_FG };

__device__ __forceinline__ bf16_t f2bf(float f) {
  unsigned u = __float_as_uint(f);
  u += 0x7fffu + ((u >> 16) & 1u);
  return (bf16_t)(u >> 16);
}
__device__ __forceinline__ float bf2f(bf16_t h) { return __uint_as_float(((unsigned)h) << 16); }
__device__ __forceinline__ unsigned pk2(float a, float b) { return (unsigned)f2bf(a) | ((unsigned)f2bf(b) << 16); }
__device__ __forceinline__ float bflo(unsigned u) { return __uint_as_float(u << 16); }
__device__ __forceinline__ float bfhi(unsigned u) { return __uint_as_float(u & 0xffff0000u); }
__device__ __forceinline__ float sigmoidf_(float x) { return __frcp_rn(1.f + __expf(-x)); }
__device__ __forceinline__ float row16_sum(float v);
__device__ __forceinline__ float wave_sum(float v) {
  v = row16_sum(v);
  const int iv = __builtin_bit_cast(int, v);
  const float s0 = __builtin_bit_cast(float, __builtin_amdgcn_readlane(iv, 0)), s1 = __builtin_bit_cast(float, __builtin_amdgcn_readlane(iv, 16));
  const float s2 = __builtin_bit_cast(float, __builtin_amdgcn_readlane(iv, 32)), s3 = __builtin_bit_cast(float, __builtin_amdgcn_readlane(iv, 48));
  return (s0 + s1) + (s2 + s3);
}
__device__ __forceinline__ float row16_sum(float v) {
  v += __builtin_bit_cast(float, __builtin_amdgcn_update_dpp(0, __builtin_bit_cast(int, v), 0x128, 0xf, 0xf, false));
  v += __builtin_bit_cast(float, __builtin_amdgcn_update_dpp(0, __builtin_bit_cast(int, v), 0x124, 0xf, 0xf, false));
  v += __builtin_bit_cast(float, __builtin_amdgcn_update_dpp(0, __builtin_bit_cast(int, v), 0x122, 0xf, 0xf, false));
  v += __builtin_bit_cast(float, __builtin_amdgcn_update_dpp(0, __builtin_bit_cast(int, v), 0x121, 0xf, 0xf, false));
  return v;
}
#define DPP_ADD(v_, ctrl_) v_ += __builtin_bit_cast(float, __builtin_amdgcn_update_dpp(0, __builtin_bit_cast(int, v_), ctrl_, 0xf, 0xf, false))
__device__ __forceinline__ void row16_sum2(float& a, float& b) {
  DPP_ADD(a, 0x128); DPP_ADD(b, 0x128); DPP_ADD(a, 0x124); DPP_ADD(b, 0x124); DPP_ADD(a, 0x122); DPP_ADD(b, 0x122); DPP_ADD(a, 0x121); DPP_ADD(b, 0x121);
}
__device__ __forceinline__ void seq_of_tok(int tok, int& start, int& L, int& ci) {
  if (tok < 4096) { start = tok & ~255; L = 256; ci = 0; }
  else { int b = (tok - 4096) >> 12; start = 4096 + (b << 12); L = 4096; ci = 1 + b; }
}

__device__ __forceinline__ size_t oz0() { size_t z = 0; asm volatile("" : "+s"(z)); return z; }
#define PWS (P.ws_ + oz0())
__device__ __forceinline__ int otid() { int t = threadIdx.x; asm volatile("" : "+v"(t)); return t; }
template <int AMODE, int NF, int NK>
__device__ __forceinline__ void gemm_acc(f32x4 (&acc)[4][NF], const bf16_t* __restrict__ A, int lda, const bf16_t* __restrict__ B, int ldb,
                                         unsigned char* smem, int k1base = 0, int Lmask = 0, int sh = 0, int ph = 0, int nbase = 0) {
  const int tid = otid(), lane = tid & 63, wid = tid >> 6, wr = wid >> 1, wc = wid & 1;
  bf16_t* sA = (bf16_t*)smem;
  bf16_t* sB = (bf16_t*)(smem + 32768);
  const bf16_t* tab = (const bf16_t*)(smem + LDS_TAB);
  uint4 ra0x, ra1x, ra2x, ra3x, rb0x, rb1x, rb2x, rb3x, ra0y, ra1y, ra2y, ra3y, rb0y, rb1y, rb2y, rb3y;
  const int row0 = tid >> 3, kc0 = tid & 7;
  const int soff = row0 * 64 + ((kc0 ^ ((row0 >> 1) & 7)) << 3);
  const int rho0 = (((row0 >> 2) & 1) << 4) | ((row0 >> 3) << 2) | (row0 & 3);
  const int soffB = rho0 * 64 + ((kc0 ^ ((rho0 >> 1) & 7)) << 3);
  const bf16_t* Ap = A + (size_t)row0 * lda + kc0 * 8;
  const bf16_t* Bp = B + (size_t)row0 * ldb + kc0 * 8;
#define GL1(r_, P_, ld_, i_, kt_) r_ = *(const uint4*)(P_ + (size_t)(32 * i_) * ld_ + (kt_) * 64);
#define GLOAD(X, kt) { if (AMODE == 0) { GL1(ra0##X, Ap, lda, 0, kt) GL1(ra1##X, Ap, lda, 1, kt) GL1(ra2##X, Ap, lda, 2, kt) GL1(ra3##X, Ap, lda, 3, kt) } \
    GL1(rb0##X, Bp, ldb, 0, kt) GL1(rb1##X, Bp, ldb, 1, kt) if (NF == 4) { GL1(rb2##X, Bp, ldb, 2, kt) GL1(rb3##X, Bp, ldb, 3, kt) } }
#define TABV(dst_) { const unsigned lo = tab[((idx << sh) + ph) & 4095]; idx = (idx + k1) & Lmask; const unsigned hi = tab[((idx << sh) + ph) & 4095]; idx = (idx + k1) & Lmask; dst_ = lo | (hi << 16); }
#define GEN1(r_, i_, kt_) { const int k1 = k1base + row0 + 32 * i_, n = nbase + (kt_) * 64 + kc0 * 8; int idx = (k1 * n) & Lmask; TABV(r_.x) TABV(r_.y) TABV(r_.z) TABV(r_.w) }
#define SSTORE(X, buf, kt) { if (AMODE == 1) { GEN1(ra0##X, 0, kt) GEN1(ra1##X, 1, kt) GEN1(ra2##X, 2, kt) GEN1(ra3##X, 3, kt) } \
    *(uint4*)(sA + (buf) * 8192 + soff) = ra0##X; *(uint4*)(sA + (buf) * 8192 + soff + 2048) = ra1##X; *(uint4*)(sA + (buf) * 8192 + soff + 4096) = ra2##X; *(uint4*)(sA + (buf) * 8192 + soff + 6144) = ra3##X; \
    *(uint4*)(sB + (buf) * 8192 + soffB) = rb0##X; *(uint4*)(sB + (buf) * 8192 + soffB + 2048) = rb1##X; \
    if (NF == 4) { *(uint4*)(sB + (buf) * 8192 + soffB + 4096) = rb2##X; *(uint4*)(sB + (buf) * 8192 + soffB + 6144) = rb3##X; } }
#define COMPUTE(buf) { \
    _Pragma("unroll") for (int ks = 0; ks < 2; ++ks) { \
      bf16x8 af[4], bfr[NF]; \
      const int q = ks * 4 + (lane >> 4); \
      _Pragma("unroll") for (int m = 0; m < 4; ++m) { const int r = wr * 64 + m * 16 + (lane & 15); af[m] = *(const bf16x8*)(sA + (buf) * 8192 + r * 64 + ((q ^ ((r >> 1) & 7)) << 3)); } \
      _Pragma("unroll") for (int n = 0; n < NF; ++n) { const int r = wc * (NF * 16) + n * 16 + (lane & 15); bfr[n] = *(const bf16x8*)(sB + (buf) * 8192 + r * 64 + ((q ^ ((r >> 1) & 7)) << 3)); } \
      _Pragma("unroll") for (int m = 0; m < 4; ++m) \
        _Pragma("unroll") for (int n = 0; n < NF; ++n) acc[m][n] = __builtin_amdgcn_mfma_f32_16x16x32_bf16(bfr[n], af[m], acc[m][n], 0, 0, 0); \
    } }
  static_assert(NK >= 4 && (NK & 1) == 0, "NK even, >= 4");
  GLOAD(x, 0)
  GLOAD(y, 1)
  SSTORE(x, 0, 0)
  __syncthreads();
#pragma unroll
  for (int kt = 0; kt < NK - 2; kt += 2) {
    GLOAD(x, kt + 2)
    COMPUTE(0)
    SSTORE(y, 1, kt + 1)
    __syncthreads();
    GLOAD(y, kt + 3)
    COMPUTE(1)
    SSTORE(x, 0, kt + 2)
    __syncthreads();
  }
  COMPUTE(0)
  SSTORE(y, 1, NK - 1)
  __syncthreads();
  COMPUTE(1)
  __syncthreads();
#undef GLOAD
#undef SSTORE
#undef COMPUTE
#undef GL1
#undef TABV
#undef GEN1
}
#define ACC_ZERO(a) ACC_ZERO_N(a, 4)
#define ACC_ZERO_N(a, NF_) _Pragma("unroll") for (int m_ = 0; m_ < 4; ++m_) _Pragma("unroll") for (int n_ = 0; n_ < NF_; ++n_) a[m_][n_] = (f32x4){0.f, 0.f, 0.f, 0.f}
#define EPI_BEGIN(a) EPI_BEGIN_N(a, 4)
#define EPI_BEGIN_N(a, NF_) { const int t_ = otid(), lane_ = t_ & 63, wid_ = t_ >> 6, wr_ = wid_ >> 1, wc_ = wid_ & 1; \
  _Pragma("unroll") for (int m_ = 0; m_ < 4; ++m_) _Pragma("unroll") for (int p_ = 0; p_ < NF_ / 2; ++p_) { \
    const int r = wr_ * 64 + m_ * 16 + (lane_ & 15), c = wc_ * (NF_ * 16) + p_ * 32 + (lane_ >> 4) * 8; f32x4& v0 = a[m_][2 * p_]; f32x4& v1 = a[m_][2 * p_ + 1];
#define EPI_END }}

__device__ __forceinline__ void phase_mod(const Params& P, unsigned char* smem) {
  float* sc = (float*)smem;
  float* part = (float*)(smem + 12288);
  const int tid = otid(), lane = tid & 63, w = tid >> 6;
  float* mod = (float*)(PWS + OFF_MOD);
  if (blockIdx.x >= 192) return;
  for (int i = tid; i < 3072; i += 256) {
    const int ci = i >> 10, k = i & 1023;
    const float c = ci == 0 ? P.in[I_CCTX][k] : P.in[I_C][(ci - 1) * 1024 + k];
    sc[i] = c * sigmoidf_(c);
  }
  __syncthreads();
  for (int item = blockIdx.x; item < 192; item += gridDim.x) {
    const int l = item / 96, cb = item % 96, col = cb * 64 + lane;
    const float* W = P.in[I_ADAW] + (size_t)l * 1024 * 6144 + col;
    float a0 = 0.f, a1 = 0.f, a2 = 0.f;
#pragma unroll 8
    for (int k = w * 256; k < w * 256 + 256; ++k) {
      const float wv = __builtin_nontemporal_load(W + (size_t)k * 6144);
      a0 += sc[k] * wv; a1 += sc[1024 + k] * wv; a2 += sc[2048 + k] * wv;
    }
    part[(w * 3 + 0) * 64 + lane] = a0; part[(w * 3 + 1) * 64 + lane] = a1; part[(w * 3 + 2) * 64 + lane] = a2;
    __syncthreads();
    if (tid < 192) {
      const int ci = tid >> 6;
      const float s = part[(0 * 3 + ci) * 64 + lane] + part[(1 * 3 + ci) * 64 + lane] + part[(2 * 3 + ci) * 64 + lane] + part[(3 * 3 + ci) * 64 + lane];
      mod[(size_t)(l * 3 + ci) * 6144 + col] = s + P.in[I_ADAB][l * 6144 + col];
    }
    __syncthreads();
  }
}

__device__ __forceinline__ void conv_tile(const float* __restrict__ W, int N, int K, int k0, int scol0, int nvalid, bf16_t* __restrict__ dst, int drow0, float* t) {
  const int tid = otid();
#pragma unroll
  for (int i = 0; i < 16; ++i) {
    const int kk = (tid >> 6) + 4 * i, j = tid & 63;
    t[kk * 65 + j] = (j < nvalid) ? __builtin_nontemporal_load(W + (size_t)(k0 + kk) * N + scol0 + j) : 0.f;
  }
  __syncthreads();
  {
    const int n = tid >> 2, kq = (tid & 3) * 16;
    uint4 o0, o1;
    const float* s = t + kq * 65 + n;
    o0.x = pk2(s[0], s[65]); o0.y = pk2(s[130], s[195]); o0.z = pk2(s[260], s[325]); o0.w = pk2(s[390], s[455]);
    s += 8 * 65;
    o1.x = pk2(s[0], s[65]); o1.y = pk2(s[130], s[195]); o1.z = pk2(s[260], s[325]); o1.w = pk2(s[390], s[455]);
    uint4* d = (uint4*)(dst + (size_t)(drow0 + n) * K + k0 + kq);
    d[0] = o0; d[1] = o1;
  }
  __syncthreads();
}
__device__ __forceinline__ void fold_tile(const float* __restrict__ W, int N, int K, int k0, int scol0, int sn, bf16_t* __restrict__ dst, int drow0, float* t, float* t2, const float* ctab) {
  const int tid = otid();
#pragma unroll
  for (int i = 0; i < 16; ++i) {
    const int kk = (tid >> 6) + 4 * i, j = tid & 63;
    t[kk * 65 + j] = __builtin_nontemporal_load(W + (size_t)(k0 + kk) * N + scol0 + j);
  }
  __syncthreads();
  {
    const int j = tid & 63, kq = tid >> 6;
    float acc[16];
#pragma unroll
    for (int u = 0; u < 16; ++u) acc[u] = 0.f;
    for (int i = 0; i < 64; ++i) {
      const float tv = ctab[(i * j - (sn ? 16 : 0)) & 63];
#pragma unroll
      for (int u = 0; u < 16; ++u) acc[u] += t[(kq * 16 + u) * 65 + i] * tv;
    }
    const float scl = sn ? -0.125f : 0.125f;
#pragma unroll
    for (int u = 0; u < 16; ++u) t2[(kq * 16 + u) * 65 + j] = acc[u] * scl;
  }
  __syncthreads();
  {
    const int n = tid >> 2, kq = (tid & 3) * 16;
    uint4 o0, o1;
    const float* s = t2 + kq * 65 + n;
    o0.x = pk2(s[0], s[65]); o0.y = pk2(s[130], s[195]); o0.z = pk2(s[260], s[325]); o0.w = pk2(s[390], s[455]);
    s += 8 * 65;
    o1.x = pk2(s[0], s[65]); o1.y = pk2(s[130], s[195]); o1.z = pk2(s[260], s[325]); o1.w = pk2(s[390], s[455]);
    uint4* d = (uint4*)(dst + (size_t)(drow0 + n) * K + k0 + kq);
    d[0] = o0; d[1] = o1;
  }
  __syncthreads();
}

#define CONV_ITEMS 4256
__device__ __forceinline__ void phase_convert(const Params& P, int l, unsigned char* smem, int first, int stride) {
  float* t = (float*)smem;
  float* t2 = (float*)(smem + 16640);
  float* ctab = (float*)(smem + 33280);
  { const int tq = otid(); if (tq < 64) ctab[tq] = cosf(6.283185307179586f * (float)tq / 64.f); }
  __syncthreads();
  bf16_t* WIN = (bf16_t*)(PWS + OFF_WIN);
  for (int it = first; it < CONV_ITEMS; it += stride) {
    int r = it;
    if (r < 1696) {
      const int nt = r >> 4, kt = r & 15, np = nt * 64;
      const float* W = P.in[I_WIN] + (size_t)l * 1024 * 6432;
      if (np >= 2176 && np < 2688) {
        const int z = (np - 2176) >> 6, sn = z >> 2, g = z & 3;
        fold_tile(W, 6432, 1024, kt * 64, 256 + g * 64, sn, WIN, np, t, t2, ctab);
      } else {
        int scol, nvalid = 64;
        if (np < 256) scol = np;
        else if (np < 2080) { scol = np + 256; if (np + 64 > 2080) nvalid = 2080 - np; }
        else if (np < 2176) { scol = 0; nvalid = 0; }
        else scol = np - 352;
        conv_tile(W, 6432, 1024, kt * 64, scol, nvalid, WIN, np, t);
      }
      continue;
    }
    r -= 1696;
    if (r < 256) { conv_tile(P.in[I_WBR] + (size_t)l * 1024 * 1024, 1024, 1024, (r & 15) * 64, (r >> 4) * 64, 64, (bf16_t*)(PWS + OFF_WB), (r >> 4) * 64, t); continue; }
    r -= 256;
    if (r < 256) { conv_tile(P.in[I_WOUT] + (size_t)l * 1024 * 1024, 1024, 1024, (r & 15) * 64, (r >> 4) * 64, 64, (bf16_t*)(PWS + OFF_WO), (r >> 4) * 64, t); continue; }
    r -= 256;
    if (r < 1024) { conv_tile(P.in[I_W1] + (size_t)l * 1024 * 4096, 4096, 1024, (r & 15) * 64, (r >> 4) * 64, 64, (bf16_t*)(PWS + OFF_W1), (r >> 4) * 64, t); continue; }
    r -= 1024;
    conv_tile(P.in[I_W2] + (size_t)l * 4096 * 1024, 1024, 4096, (r & 63) * 64, (r >> 6) * 64, 64, (bf16_t*)(PWS + OFF_W2), (r >> 6) * 64, t);
  }
}
__device__ __forceinline__ void phase_table(const Params& P) {
  if (blockIdx.x == gridDim.x - 1) {
    bf16_t* tab = (bf16_t*)(PWS + OFF_TAB);
    for (int i = otid(); i < 4096; i += 256) tab[i] = f2bf(cosf(6.283185307179586f * (float)i / 4096.f));
  }
}

__device__ __forceinline__ void phase_norm(const Params& P, int l, int which) {
  const int tid = otid(), lane = tid & 63, gw = blockIdx.x * 4 + (tid >> 6), nw = gridDim.x * 4;
  const float* mod = (const float*)(PWS + OFF_MOD);
  bf16_t* H = (bf16_t*)(PWS + OFF_H);
  float omega[4] = {0.f, 0.f, 0.f, 0.f};
  if (which == 0 && l == 0) {
#pragma unroll
    for (int e = 0; e < 4; ++e) omega[e] = 1.0f / powf(10000.0f, (float)(lane * 4 + e) / 256.0f);
  }
  for (int tok = gw; tok < NT; tok += nw) {
    int start, L, ci; seq_of_tok(tok, start, L, ci);
    float* xr = P.out + (size_t)tok * 1024;
    f32x4 v[4];
    if (which == 0 && l == 0) {
      const float* src = tok < 4096 ? P.in[I_XP] + (size_t)tok * 1024 : P.in[I_XS] + (size_t)(tok - 4096) * 1024;
      const int n = tok - start;
#pragma unroll
      for (int j = 0; j < 4; ++j) {
        v[j] = *(const f32x4*)(src + j * 256 + lane * 4);
        if (tok >= 4096) {
          const float pos = (j < 2) ? (float)(n >> 6) : (float)(n & 63);
#pragma unroll
          for (int e = 0; e < 4; ++e) {
            const float ang = pos * omega[e];
            v[j][e] += (j & 1) ? cosf(ang) : sinf(ang);
          }
        }
        *(f32x4*)(xr + j * 256 + lane * 4) = v[j];
      }
    } else {
#pragma unroll
      for (int j = 0; j < 4; ++j) v[j] = *(const f32x4*)(xr + j * 256 + lane * 4);
    }
    float ss = 0.f;
#pragma unroll
    for (int j = 0; j < 4; ++j) ss += v[j][0] * v[j][0] + v[j][1] * v[j][1] + v[j][2] * v[j][2] + v[j][3] * v[j][3];
    ss = wave_sum(ss);
    const float rs = rsqrtf(ss * (1.f / 1024.f) + 1e-6f);
    if (which == 2) {
#pragma unroll
      for (int j = 0; j < 4; ++j) {
        const f32x4 g = *(const f32x4*)(P.in[I_FG] + j * 256 + lane * 4);
        f32x4 o;
#pragma unroll
        for (int e = 0; e < 4; ++e) o[e] = v[j][e] * rs * g[e];
        *(f32x4*)(xr + j * 256 + lane * 4) = o;
      }
    } else {
      const float* gsrc = (which == 0 ? P.in[I_N1G] : P.in[I_N2G]) + l * 1024;
      const float* mrow = mod + (size_t)(l * 3 + ci) * 6144 + (which == 0 ? 0 : 3072);
#pragma unroll
      for (int j = 0; j < 4; ++j) {
        const int c0 = j * 256 + lane * 4;
        const f32x4 g = *(const f32x4*)(gsrc + c0), shv = *(const f32x4*)(mrow + c0), scv = *(const f32x4*)(mrow + 1024 + c0);
        float o[4];
#pragma unroll
        for (int e = 0; e < 4; ++e) o[e] = v[j][e] * rs * g[e] * (1.f + scv[e]) + shv[e];
        uint2 pk; pk.x = pk2(o[0], o[1]); pk.y = pk2(o[2], o[3]);
        *(uint2*)(H + (size_t)tok * 1024 + c0) = pk;
      }
    }
  }
}

struct TL { int x, j, n; };
#define TILE_LOOP(NTN_) for (int q_ = tl.j, x_ = tl.x, nl_ = tl.n, NTN__ = (NTN_); q_ < 12 * (NTN_); q_ += nl_)
#ifdef TILE_STRIP
#define TILE_MT (12 * x_ + (q_ / (TILE_STRIP * NTN__)) * TILE_STRIP + q_ % TILE_STRIP)
#define TILE_NT ((q_ % (TILE_STRIP * NTN__)) / TILE_STRIP)
#else
#define TILE_MT (12 * x_ + q_ % 12)
#define TILE_NT (q_ / 12)
#endif
__device__ __forceinline__ void phase_gemm1(const Params& P, unsigned char* smem, const TL& tl) {
  const bf16_t* H = (const bf16_t*)(PWS + OFF_H);
  const bf16_t* WIN = (const bf16_t*)(PWS + OFF_WIN);
  bf16_t* U = (bf16_t*)(PWS + OFF_U);
  bf16_t* ZT = (bf16_t*)(PWS + OFF_ZT);
  TILE_LOOP(21) {
    const int mt = TILE_MT, nt = TILE_NT, m0 = mt * 128;
    f32x4 acc[4][4]; ACC_ZERO(acc);
    if (nt < 17) {
      gemm_acc<0, 4, 16>(acc, H + (size_t)m0 * 1024, 1024, WIN + (size_t)nt * 128 * 1024, 1024, smem);
      EPI_BEGIN(acc)
        uint4 pk; pk.x = pk2(v0[0], v0[1]); pk.y = pk2(v0[2], v0[3]); pk.z = pk2(v1[0], v1[1]); pk.w = pk2(v1[2], v1[3]);
        *(uint4*)(U + (size_t)(m0 + r) * NU + nt * 128 + c) = pk;
      EPI_END
    } else {
      const int z0 = (nt - 17) * 128;
      gemm_acc<0, 4, 16>(acc, WIN + (size_t)(2176 + z0) * 1024, 1024, H + (size_t)m0 * 1024, 1024, smem);
      EPI_BEGIN(acc)
        uint4 pk; pk.x = pk2(v0[0], v0[1]); pk.y = pk2(v0[2], v0[3]); pk.z = pk2(v1[0], v1[1]); pk.w = pk2(v1[2], v1[3]);
        *(uint4*)(ZT + (size_t)(z0 + r) * NT + m0 + c) = pk;
      EPI_END
    }
  }
}
__device__ __forceinline__ void phase_gemm_mlog(const Params& P, unsigned char* smem, const TL& tl) {
  const bf16_t* H = (const bf16_t*)(PWS + OFF_H);
  const bf16_t* WIN = (const bf16_t*)(PWS + OFF_WIN);
  bf16_t* Mg = (bf16_t*)(PWS + OFF_M);
  TILE_LOOP(32) {
    const int mt = TILE_MT, nt = TILE_NT, m0 = mt * 128;
    f32x4 acc[4][4]; ACC_ZERO(acc);
    gemm_acc<0, 4, 16>(acc, H + (size_t)m0 * 1024, 1024, WIN + (size_t)(2688 + nt * 128) * 1024, 1024, smem);
    EPI_BEGIN(acc)
      uint4 pk; pk.x = pk2(v0[0], v0[1]); pk.y = pk2(v0[2], v0[3]); pk.z = pk2(v1[0], v1[1]); pk.w = pk2(v1[2], v1[3]);
      *(uint4*)(Mg + (size_t)(m0 + r) * 4096 + nt * 128 + c) = pk;
    EPI_END
  }
}
__device__ __forceinline__ void phase_merge(const Params& P, unsigned char* smem, const TL& tl) {
  const bf16_t* YS = (const bf16_t*)(PWS + OFF_YS);
  const bf16_t* WB = (const bf16_t*)(PWS + OFF_WB);
  const bf16_t* Mg = (const bf16_t*)(PWS + OFF_M);
  bf16_t* MG = (bf16_t*)(PWS + OFF_U);
  TILE_LOOP(16) {
    const int mt = TILE_MT, nt = TILE_NT, m0 = mt * 128, n0 = nt * 64;
    f32x4 macc[4][2]; ACC_ZERO_N(macc, 2);
    const int t_ = otid(), lane_ = t_ & 63, wid_ = t_ >> 6, wr_ = wid_ >> 1, wc_ = wid_ & 1;
    const bf16_t* gp = Mg + (size_t)(m0 + wr_ * 64 + (lane_ & 15)) * 4096 + n0 + wc_ * 32 + (lane_ >> 4) * 8;
#define MROW(m, gX) { const uint4 gv = gX; \
      macc[m][0][0] += sigmoidf_(bflo(gv.x)) * acc[m][0][0]; macc[m][0][1] += sigmoidf_(bfhi(gv.x)) * acc[m][0][1]; \
      macc[m][0][2] += sigmoidf_(bflo(gv.y)) * acc[m][0][2]; macc[m][0][3] += sigmoidf_(bfhi(gv.y)) * acc[m][0][3]; \
      macc[m][1][0] += sigmoidf_(bflo(gv.z)) * acc[m][1][0]; macc[m][1][1] += sigmoidf_(bfhi(gv.z)) * acc[m][1][1]; \
      macc[m][1][2] += sigmoidf_(bflo(gv.w)) * acc[m][1][2]; macc[m][1][3] += sigmoidf_(bfhi(gv.w)) * acc[m][1][3]; }
#pragma unroll 1
    for (int i = 0; i < 4; ++i) {
      f32x4 acc[4][2]; ACC_ZERO_N(acc, 2);
      const uint4 g0 = *(const uint4*)(gp + i * 1024), g1 = *(const uint4*)(gp + (size_t)16 * 4096 + i * 1024),
                  g2 = *(const uint4*)(gp + (size_t)32 * 4096 + i * 1024), g3 = *(const uint4*)(gp + (size_t)48 * 4096 + i * 1024);
      gemm_acc<0, 2, 4>(acc, YS + (size_t)m0 * 1024 + i * 256, 1024, WB + (size_t)n0 * 1024 + i * 256, 1024, smem);
      MROW(0, g0) MROW(1, g1) MROW(2, g2) MROW(3, g3)
    }
#undef MROW
    EPI_BEGIN_N(macc, 2)
      uint4 pk; pk.x = pk2(v0[0], v0[1]); pk.y = pk2(v0[2], v0[3]); pk.z = pk2(v1[0], v1[1]); pk.w = pk2(v1[2], v1[3]);
      *(uint4*)(MG + (size_t)(m0 + r) * 1024 + n0 + c) = pk;
    EPI_END
  }
}
__device__ __forceinline__ void phase_gemm_res(const Params& P, int l, int which, unsigned char* smem, bool dry, const TL& tl) {
  const bf16_t* A = (const bf16_t*)(PWS + (which == 0 ? OFF_U : OFF_M));
  const bf16_t* W = (const bf16_t*)(PWS + (which == 0 ? OFF_WO : OFF_W2));
  const int K = which == 0 ? 1024 : 4096;
  const float* mod = (const float*)(PWS + OFF_MOD);
  TILE_LOOP(16) {
    const int mt = TILE_MT, nt = TILE_NT, m0 = mt * 128, n0 = nt * 64;
    int start, L, ci; seq_of_tok(m0, start, L, ci);
    const float* gate = mod + (size_t)(l * 3 + ci) * 6144 + (which == 0 ? 2048 : 5120);
    f32x4 acc[4][2]; ACC_ZERO_N(acc, 2);
    #pragma unroll 1
    for (int kc = 0; kc < K; kc += 1024) gemm_acc<0, 2, 16>(acc, A + (size_t)m0 * K + kc, K, W + (size_t)n0 * K + kc, K, smem);
    EPI_BEGIN_N(acc, 2)
      float* xp = P.out + (size_t)(m0 + r) * 1024 + n0 + c;
      const f32x4 g0 = *(const f32x4*)(gate + n0 + c), g1 = *(const f32x4*)(gate + n0 + c + 4);
      f32x4 x0 = *(const f32x4*)xp, x1 = *(const f32x4*)(xp + 4);
      x0[0] += g0[0] * v0[0]; x0[1] += g0[1] * v0[1]; x0[2] += g0[2] * v0[2]; x0[3] += g0[3] * v0[3];
      x1[0] += g1[0] * v1[0]; x1[1] += g1[1] * v1[1]; x1[2] += g1[2] * v1[2]; x1[3] += g1[3] * v1[3];
      if (!dry) { *(f32x4*)xp = x0; *(f32x4*)(xp + 4) = x1; }
    EPI_END
  }
}
__device__ __forceinline__ void phase_mlp_up(const Params& P, unsigned char* smem, const TL& tl) {
  const bf16_t* H = (const bf16_t*)(PWS + OFF_H);
  const bf16_t* W1 = (const bf16_t*)(PWS + OFF_W1);
  bf16_t* HID = (bf16_t*)(PWS + OFF_M);
  TILE_LOOP(32) {
    const int mt = TILE_MT, nt = TILE_NT, m0 = mt * 128;
    f32x4 acc[4][4]; ACC_ZERO(acc);
    gemm_acc<0, 4, 16>(acc, H + (size_t)m0 * 1024, 1024, W1 + (size_t)nt * 128 * 1024, 1024, smem);
    EPI_BEGIN(acc)
      float o[8];
#pragma unroll
      for (int e = 0; e < 4; ++e) { const float a = fmaxf(v0[e], 0.f), b = fmaxf(v1[e], 0.f); o[e] = a * a; o[4 + e] = b * b; }
      uint4 pk; pk.x = pk2(o[0], o[1]); pk.y = pk2(o[2], o[3]); pk.z = pk2(o[4], o[5]); pk.w = pk2(o[6], o[7]);
      *(uint4*)(HID + (size_t)(m0 + r) * 4096 + nt * 128 + c) = pk;
    EPI_END
  }
}

__device__ __forceinline__ void prep_tile(const Params& P, int l, int tile, unsigned char* smem) {
  const int tid = otid(), tok0 = tile * 32;
  int start, L, ci; seq_of_tok(tok0, start, L, ci);
  const bf16_t* U = (const bf16_t*)(PWS + OFF_U);
  bf16_t* YS = (bf16_t*)(PWS + OFF_YS);
  float* pl = (float*)smem;
  bf16_t* zw = (bf16_t*)(smem + 32768);
  float* tw = (float*)(smem + 32768);
  float* ca = (float*)(smem + 49152);
  const int col = tid, g = col >> 6;
#pragma unroll
  for (int i = 0; i < 6; ++i) {
    const int c = tid + 256 * i;
    if (c < 47 * 32) {
      const int rr = c >> 5, cc = (c & 31) * 8, t = tok0 - 8 + rr - start;
      uint4 v = make_uint4(0u, 0u, 0u, 0u);
      if (t >= 0 && t < L) v = *(const uint4*)(U + (size_t)(start + t) * NU + UP + cc);
      *(uint4*)(zw + rr * 256 + cc) = v;
    }
  }
  __syncthreads();
  {
    const int half = 1 << g, win = 2 << g;
#pragma unroll 4
    for (int tt = 0; tt < 32; ++tt) {
      const int t = tok0 + tt - start;
      const int lo = max(t - half, 0), hi = min(t + half - 1, L - 1);
      float s = 0.f;
      const bf16_t* zp = zw + (tt + 8 - half) * 256 + col;
      for (int p = 0; p < win; ++p) s += bf2f(zp[p * 256]);
      pl[tt * 256 + col] = s / (float)(hi - lo + 1) - bf2f(zw[(tt + 8) * 256 + col]);
    }
  }
  __syncthreads();
#pragma unroll
  for (int i = 0; i < 3; ++i) {
    const int c = tid + 256 * i, tt = c / 24, j8 = (c % 24) * 8;
    const uint4 v = *(const uint4*)(U + (size_t)(tok0 + tt) * NU + UCW + j8);
    const unsigned w4[4] = {v.x, v.y, v.z, v.w};
#pragma unroll
    for (int e2 = 0; e2 < 4; ++e2) {
      const float x0 = bflo(w4[e2]), x1 = bfhi(w4[e2]);
      const int jj = j8 + 2 * e2;
      if (jj < 128) { tw[tt * 128 + jj] = 1.f - 2.f * __frcp_rn(1.f + __expf(2.f * x0)); tw[tt * 128 + jj + 1] = 1.f - 2.f * __frcp_rn(1.f + __expf(2.f * x1)); }
      else { ca[tt * 64 + jj - 128] = x0; ca[tt * 64 + jj - 127] = x1; }
    }
  }
  {
    float wreg[64];
    const float* pw = P.in[I_POOLW] + (size_t)(l * 4 + g) * 4096 + (col & 63);
#pragma unroll
    for (int cc = 0; cc < 64; ++cc) wreg[cc] = pw[cc * 64];
    const float ps = P.in[I_POOLS][l * 256 + col];
#pragma unroll 2
    for (int tt = 0; tt < 32; ++tt) {
      float a0 = 0.f, a1 = 0.f;
#pragma unroll
      for (int c4 = 0; c4 < 16; ++c4) {
        const f32x4 p4 = *(const f32x4*)(pl + tt * 256 + g * 64 + c4 * 4);
        a0 += p4[0] * wreg[c4 * 4] + p4[2] * wreg[c4 * 4 + 2];
        a1 += p4[1] * wreg[c4 * 4 + 1] + p4[3] * wreg[c4 * 4 + 3];
      }
      YS[(size_t)(tok0 + tt) * 1024 + col] = f2bf((a0 + a1) * ps);
    }
  }
  __syncthreads();
  float* Wd = (float*)(PWS + OFF_M + M_W);
  float aF[32], aB[32];
#pragma unroll 1
  for (int dir = 0; dir < 2; ++dir) {
    {
      float wreg[64];
      const float* bw = P.in[I_BW] + (size_t)(l * 2 + dir) * 64 * 256 + col;
#pragma unroll
      for (int r = 0; r < 64; ++r) wreg[r] = bw[r * 256];
      const float w0 = P.in[I_W0][(l * 2 + dir) * 256 + col];
#pragma unroll 2
      for (int tt = 0; tt < 32; ++tt) {
        float a0 = w0, a1 = 0.f;
#pragma unroll
        for (int r4 = 0; r4 < 16; ++r4) {
          const f32x4 x4 = *(const f32x4*)(tw + tt * 128 + dir * 64 + r4 * 4);
          a0 += x4[0] * wreg[r4 * 4] + x4[2] * wreg[r4 * 4 + 2];
          a1 += x4[1] * wreg[r4 * 4 + 1] + x4[3] * wreg[r4 * 4 + 3];
        }
        Wd[((size_t)dir * NT + tok0 + tt) * 256 + col] = __expf(-0.606531f * sigmoidf_(a0 + a1));
      }
    }
    {
      float wreg[32];
      const float* ba = P.in[I_BA] + (size_t)(l * 2 + dir) * 32 * 256 + col;
#pragma unroll
      for (int r = 0; r < 32; ++r) wreg[r] = ba[r * 256];
      const float a0c = P.in[I_A0][(l * 2 + dir) * 256 + col];
#pragma unroll
      for (int tt = 0; tt < 32; ++tt) {
        float a0 = a0c, a1 = 0.f;
#pragma unroll
        for (int r4 = 0; r4 < 8; ++r4) {
          const f32x4 x4 = *(const f32x4*)(ca + tt * 64 + dir * 32 + r4 * 4);
          a0 += x4[0] * wreg[r4 * 4] + x4[2] * wreg[r4 * 4 + 2];
          a1 += x4[1] * wreg[r4 * 4 + 1] + x4[3] * wreg[r4 * 4 + 3];
        }
        const float a = sigmoidf_(a0 + a1);
        if (dir == 0) aF[tt] = a; else aB[tt] = a;
      }
    }
  }
  {
    bf16_t* Rr = (bf16_t*)(PWS + OFF_M + M_R);
    bf16_t* Vv = (bf16_t*)(PWS + OFF_M + M_V);
    bf16_t* KKn = (bf16_t*)(PWS + OFF_M + M_KK);
    bf16_t* KD = (bf16_t*)(PWS + OFF_M + M_KD);
    bf16_t* Bb = (bf16_t*)(PWS + OFF_M + M_B);
    float* ORW = (float*)(PWS + OFF_ORW);
    const float mur = P.in[I_MU][l * 768 + col], muk = P.in[I_MU][l * 768 + 256 + col], muv = P.in[I_MU][l * 768 + 512 + col];
    const float kkp = P.in[I_KKP][l * 256 + col], ka = P.in[I_KA][l * 256 + col];
#pragma unroll
    for (int tt = 0; tt < 32; ++tt) {
      const int tok = tok0 + tt, t = tok - start;
      const bf16_t* u0 = U + (size_t)tok * NU;
      const float zr = bf2f(u0[UR + col]), zk = bf2f(u0[UK + col]), zv = bf2f(u0[UV + col]);
      float pr = 0.f, pk = 0.f, pv = 0.f, nr = 0.f, nk = 0.f, nv = 0.f;
      if (t > 0) { pr = bf2f(u0[UR + col - NU]); pk = bf2f(u0[UK + col - NU]); pv = bf2f(u0[UV + col - NU]); }
      if (t < L - 1) { nr = bf2f(u0[UR + col + NU]); nk = bf2f(u0[UK + col + NU]); nv = bf2f(u0[UV + col + NU]); }
      const float r = zr + mur * (0.5f * (pr + nr) - zr);
      const float k = zk + muk * (0.5f * (pk + nk) - zk);
      const float v = zv + muv * (0.5f * (pv + nv) - zv);
      float kk = k * kkp;
      const float ss = wave_sum(kk * kk);
      kk *= rsqrtf(ss + 1e-6f);
      const size_t o = (size_t)tok * 256 + col;
      Rr[o] = f2bf(r); Vv[o] = f2bf(v); KKn[o] = f2bf(kk);
      KD[o] = f2bf(k * (1.f + (aF[tt] - 1.f) * ka)); KD[(size_t)NT * 256 + o] = f2bf(k * (1.f + (aB[tt] - 1.f) * ka));
      Bb[o] = f2bf(kk * aF[tt]); Bb[(size_t)NT * 256 + o] = f2bf(kk * aB[tt]);
      ORW[o] = 0.f;
    }
  }
  __syncthreads();
}

__device__ __forceinline__ void gla_bcum(const Params& P, int l, int dir, int h, int c0, float* gs) {
  const int tid = otid();
  const bf16_t* U = (const bf16_t*)(PWS + OFF_U);
  {
    const int pp = tid >> 2, dq = tid & 3, tok = dir ? c0 + 63 - pp : c0 + pp;
    const uint4* cp = (const uint4*)(U + (size_t)tok * NU + UCAL + dir * 16);
    const uint4 c0v = cp[0], c1v = cp[1];
    float cal[16];
    cal[0] = bflo(c0v.x); cal[1] = bfhi(c0v.x); cal[2] = bflo(c0v.y); cal[3] = bfhi(c0v.y); cal[4] = bflo(c0v.z); cal[5] = bfhi(c0v.z); cal[6] = bflo(c0v.w); cal[7] = bfhi(c0v.w);
    cal[8] = bflo(c1v.x); cal[9] = bfhi(c1v.x); cal[10] = bflo(c1v.y); cal[11] = bfhi(c1v.y); cal[12] = bflo(c1v.z); cal[13] = bfhi(c1v.z); cal[14] = bflo(c1v.w); cal[15] = bfhi(c1v.w);
    const float* ab = P.in[I_GAB] + (size_t)(l * 2 + dir) * 16 * 128 + h * 32 + dq * 8;
    const float* bias = P.in[I_GABIAS] + (l * 2 + dir) * 128 + h * 32 + dq * 8;
#pragma unroll
    for (int dd = 0; dd < 8; ++dd) {
      float x = bias[dd];
#pragma unroll
      for (int r = 0; r < 16; ++r) x += cal[r] * ab[r * 128 + dd];
      const float ls = fminf(x, 0.f) - __logf(1.f + __expf(-fabsf(x)));
      gs[pp * 32 + dq * 8 + dd] = ls * (1.f / 16.f);
    }
  }
  __syncthreads();
  {
    float* segs = gs + 10240;
    const int d = tid & 31, sg_ = tid >> 5;
    float v[8], run = 0.f;
#pragma unroll
    for (int i = 0; i < 8; ++i) { run += gs[(sg_ * 8 + i) * 32 + d]; v[i] = run; }
    segs[sg_ * 32 + d] = run;
    __syncthreads();
    float off = 0.f;
#pragma unroll
    for (int s2 = 0; s2 < 7; ++s2) off += (s2 < sg_) ? segs[s2 * 32 + d] : 0.f;
#pragma unroll
    for (int i = 0; i < 8; ++i) gs[(sg_ * 8 + i) * 32 + d] = v[i] + off;
  }
  __syncthreads();
}
__device__ __forceinline__ void gla_g1(const Params& P, int l, int item, unsigned char* smem) {
  const int tid = otid();
  const int dir = item & 1, h = (item >> 1) & 3, cgi = item >> 3, c0 = cgi * 64;
  const bf16_t* U = (const bf16_t*)(PWS + OFF_U);
  float* gs = (float*)smem;
  float* kt = (float*)(smem + 8192);
  float* vs = (float*)(smem + 16384);
  gla_bcum(P, l, dir, h, c0, gs);
  {
    const int pp = tid >> 2, q4 = tid & 3, tok = dir ? c0 + 63 - pp : c0 + pp;
    const uint4 kv = *(const uint4*)(U + (size_t)tok * NU + UGK + h * 32 + q4 * 8);
    const unsigned kw[4] = {kv.x, kv.y, kv.z, kv.w};
#pragma unroll
    for (int i = 0; i < 4; ++i) {
      const int d = q4 * 8 + 2 * i;
      kt[pp * 32 + d] = bflo(kw[i]) * __expf(gs[63 * 32 + d] - gs[pp * 32 + d]);
      kt[pp * 32 + d + 1] = bfhi(kw[i]) * __expf(gs[63 * 32 + d + 1] - gs[pp * 32 + d + 1]);
    }
    const uint4* vp = (const uint4*)(U + (size_t)tok * NU + UGV + h * 64 + q4 * 16);
    const uint4 v0 = vp[0], v1 = vp[1];
    const unsigned vw[8] = {v0.x, v0.y, v0.z, v0.w, v1.x, v1.y, v1.z, v1.w};
#pragma unroll
    for (int i = 0; i < 8; ++i) { vs[pp * 64 + q4 * 16 + 2 * i] = bflo(vw[i]); vs[pp * 64 + q4 * 16 + 2 * i + 1] = bfhi(vw[i]); }
  }
  __syncthreads();
  {
    const int e = tid & 63, dq = tid >> 6;
    float acc[8];
#pragma unroll
    for (int dd = 0; dd < 8; ++dd) acc[dd] = 0.f;
    for (int pp = 0; pp < 64; ++pp) {
      const float vv = vs[pp * 64 + e];
#pragma unroll
      for (int dd = 0; dd < 8; ++dd) acc[dd] += kt[pp * 32 + dq * 8 + dd] * vv;
    }
    float* S = (float*)(PWS + OFF_M + M_GS) + (size_t)item * 2080;
#pragma unroll
    for (int dd = 0; dd < 8; ++dd) S[(dq * 8 + dd) * 64 + e] = acc[dd];
    if (tid < 32) S[2048 + tid] = __expf(gs[63 * 32 + tid]);
  }
  __syncthreads();
}
__device__ __forceinline__ void gla_g2(const Params& P, int l, int item, unsigned char* smem) {
  const int tid = otid();
  const int h = item & 3, cgi = item >> 2, c0 = cgi * 64;
  int start, L, ci; seq_of_tok(c0, start, L, ci);
  const int cfirst = start >> 6, nc = L >> 6;
  const bf16_t* U = (const bf16_t*)(PWS + OFF_U);
  const float* GS = (const float*)(PWS + OFF_M + M_GS);
  float* gs = (float*)smem;
  float* qt = (float*)(smem + 8192);
  float* kt = (float*)(smem + 16384);
  float* vs = (float*)(smem + 24576);
  float* att = (float*)(smem + 40960);
  float* Sp = (float*)(smem + 57600);
  const int e = tid & 63, pq = tid >> 6;
  float oacc[16];
#pragma unroll
  for (int i = 0; i < 16; ++i) oacc[i] = 0.f;
#pragma unroll 1
  for (int dir = 0; dir < 2; ++dir) {
    gla_bcum(P, l, dir, h, c0, gs);
    {
      float S[8];
      if (ci == 0) {
#pragma unroll
        for (int dd = 0; dd < 8; ++dd) S[dd] = 0.f;
      } else {
        const float* s0 = P.in[I_SGL] + ((((size_t)(ci - 1) * 2 + l) * 2 + dir) * 4 + h) * 2048;
#pragma unroll
        for (int dd = 0; dd < 8; ++dd) S[dd] = s0[(pq * 8 + dd) * 64 + e];
      }
      if (dir == 0) {
        for (int j = cfirst; j < cgi; ++j) {
          const float* sj = GS + (size_t)((j * 4 + h) * 2 + 0) * 2080;
#pragma unroll
          for (int dd = 0; dd < 8; ++dd) S[dd] = sj[2048 + pq * 8 + dd] * S[dd] + sj[(pq * 8 + dd) * 64 + e];
        }
      } else {
        for (int j = cfirst + nc - 1; j > cgi; --j) {
          const float* sj = GS + (size_t)((j * 4 + h) * 2 + 1) * 2080;
#pragma unroll
          for (int dd = 0; dd < 8; ++dd) S[dd] = sj[2048 + pq * 8 + dd] * S[dd] + sj[(pq * 8 + dd) * 64 + e];
        }
      }
#pragma unroll
      for (int dd = 0; dd < 8; ++dd) Sp[(pq * 8 + dd) * 64 + e] = S[dd];
      const bool last = dir == 0 ? (cgi == cfirst + nc - 1) : (cgi == cfirst);
      if (ci == 0 && last) {
        const float* sj = GS + (size_t)((cgi * 4 + h) * 2 + dir) * 2080;
        const int b = start >> 8;
        float* dst = P.out + OUT_SG + ((((size_t)b * 2 + l) * 2 + dir) * 4 + h) * 2048;
#pragma unroll
        for (int dd = 0; dd < 8; ++dd) dst[(pq * 8 + dd) * 64 + e] = sj[2048 + pq * 8 + dd] * S[dd] + sj[(pq * 8 + dd) * 64 + e];
      }
    }
    {
      const int pp = tid >> 2, q4 = tid & 3, tok = dir ? c0 + 63 - pp : c0 + pp;
      const uint4 qv = *(const uint4*)(U + (size_t)tok * NU + UGQ + h * 32 + q4 * 8);
      const uint4 kv = *(const uint4*)(U + (size_t)tok * NU + UGK + h * 32 + q4 * 8);
      const unsigned qw[4] = {qv.x, qv.y, qv.z, qv.w};
      const unsigned kw[4] = {kv.x, kv.y, kv.z, kv.w};
#pragma unroll
      for (int i = 0; i < 4; ++i) {
        const int d = q4 * 8 + 2 * i;
        const float b0 = gs[pp * 32 + d], b1 = gs[pp * 32 + d + 1];
        qt[pp * 32 + d] = bflo(qw[i]) * 0.17677669529663687f * __expf(b0);
        qt[pp * 32 + d + 1] = bfhi(qw[i]) * 0.17677669529663687f * __expf(b1);
        kt[pp * 32 + d] = bflo(kw[i]) * __expf(-b0);
        kt[pp * 32 + d + 1] = bfhi(kw[i]) * __expf(-b1);
      }
      const uint4* vp = (const uint4*)(U + (size_t)tok * NU + UGV + h * 64 + q4 * 16);
      const uint4 v0 = vp[0], v1 = vp[1];
      const unsigned vw[8] = {v0.x, v0.y, v0.z, v0.w, v1.x, v1.y, v1.z, v1.w};
#pragma unroll
      for (int i = 0; i < 8; ++i) { vs[pp * 64 + q4 * 16 + 2 * i] = bflo(vw[i]); vs[pp * 64 + q4 * 16 + 2 * i + 1] = bfhi(vw[i]); }
    }
    __syncthreads();
    {
      const int pp = tid >> 2, sq = tid & 3;
      float qr[32];
#pragma unroll
      for (int d = 0; d < 32; ++d) qr[d] = qt[pp * 32 + d];
#pragma unroll 1
      for (int si = 0; si < 16; ++si) {
        const int s = sq * 16 + si;
        float a = 0.f;
        if (s <= pp) {
#pragma unroll
          for (int d = 0; d < 32; ++d) a += qr[d] * kt[s * 32 + d];
        }
        att[pp * 65 + s] = a;
      }
    }
    __syncthreads();
    {
#pragma unroll 2
      for (int s = 0; s < 64; ++s) {
        const float vv = vs[s * 64 + e];
#pragma unroll
        for (int i = 0; i < 16; ++i) { const int tau = pq * 16 + i, pp = dir ? 63 - tau : tau; oacc[i] += att[pp * 65 + s] * vv; }
      }
#pragma unroll 2
      for (int d = 0; d < 32; ++d) {
        const float sv = Sp[d * 64 + e];
#pragma unroll
        for (int i = 0; i < 16; ++i) { const int tau = pq * 16 + i, pp = dir ? 63 - tau : tau; oacc[i] += qt[pp * 32 + d] * sv; }
      }
    }
    __syncthreads();
  }
  float* OG = (float*)(PWS + OFF_M + M_OG);
#pragma unroll
  for (int i = 0; i < 16; ++i) OG[(size_t)(c0 + pq * 16 + i) * 256 + h * 64 + e] = oacc[i];
}

#define SC_BUF 22528
__device__ __forceinline__ void rwkv_scan(const Params& P, int l, int item, bool dry, unsigned char* smem) {
  const int tid = otid();
  int seq, sub;
  if (item < 64) { seq = 16 + (item >> 5); sub = item & 31; } else { seq = (item - 64) >> 5; sub = (item - 64) & 31; }
  const int h = sub >> 3, dir = (sub >> 2) & 1, rg = sub & 3;
  const int start = seq < 16 ? seq * 256 : 4096 + (seq - 16) * 4096, L = seq < 16 ? 256 : 4096;
  const int rowl = tid >> 4, j = tid & 15, row = rg * 16 + rowl;
  unsigned char* ws = PWS;
  const float* Wd = (const float*)(ws + OFF_M + M_W) + (size_t)dir * NT * 256 + h * 64 + j * 4;
  const bf16_t* KD = (const bf16_t*)(ws + OFF_M + M_KD) + (size_t)dir * NT * 256 + h * 64 + j * 4;
  const bf16_t* Bb = (const bf16_t*)(ws + OFF_M + M_B) + (size_t)dir * NT * 256 + h * 64 + j * 4;
  const bf16_t* Rr = (const bf16_t*)(ws + OFF_M + M_R) + h * 64 + j * 4;
  const bf16_t* KKn = (const bf16_t*)(ws + OFF_M + M_KK) + h * 64 + j * 4;
  const bf16_t* Vv = (const bf16_t*)(ws + OFF_M + M_V) + h * 64 + rg * 16 + j;
  float* ORW = (float*)(ws + OFF_ORW) + h * 64 + rg * 16 + j;
  typedef float f32x2 __attribute__((ext_vector_type(2)));
  f32x2 S01, S23;
  if (seq < 16) {
    S01 = (f32x2){0.f, 0.f}; S23 = (f32x2){0.f, 0.f};
  } else {
    const f32x4 s0 = *(const f32x4*)(P.in[I_SRW] + (((((size_t)(seq - 16) * 2 + l) * 2 + dir) * 4 + h) * 64 + row) * 64 + j * 4);
    S01 = (f32x2){s0[0], s0[1]}; S23 = (f32x2){s0[2], s0[3]};
  }
  f32x4 gw; uint2 gkd, gb, gkk, gr; unsigned gv;
  const int nch = L >> 4;
#define SC_TOK(c_) ((size_t)(start + (dir ? L - 1 - ((c_) * 16 + rowl) : (c_) * 16 + rowl)))
#define SC_LOAD(c_) { const size_t tk = SC_TOK(c_) * 256; gw = *(const f32x4*)(Wd + tk); gkd = *(const uint2*)(KD + tk); gb = *(const uint2*)(Bb + tk); \
    gkk = *(const uint2*)(KKn + tk); gr = *(const uint2*)(Rr + tk); gv = Vv[tk]; }
#define SC_STORE(b_) { float* base = (float*)(smem + (b_) * SC_BUF) + rowl * 64 + j * 4; \
    *(f32x4*)(base) = gw; \
    *(f32x4*)(base + 1024) = (f32x4){bflo(gkd.x), bfhi(gkd.x), bflo(gkd.y), bfhi(gkd.y)}; \
    *(f32x4*)(base + 2048) = (f32x4){bflo(gb.x), bfhi(gb.x), bflo(gb.y), bfhi(gb.y)}; \
    *(f32x4*)(base + 3072) = (f32x4){bflo(gkk.x), bfhi(gkk.x), bflo(gkk.y), bfhi(gkk.y)}; \
    *(f32x4*)(base + 4096) = (f32x4){bflo(gr.x), bfhi(gr.x), bflo(gr.y), bfhi(gr.y)}; \
    ((float*)(smem + (b_) * SC_BUF + 20480))[j * 16 + rowl] = __uint_as_float(gv << 16); }
  SC_LOAD(0)
  SC_STORE(0)
  if (nch > 1) SC_LOAD(1)
  __syncthreads();
#pragma unroll 1
  for (int c = 0; c < nch; ++c) {
    const float* buf = (const float*)(smem + (c & 1) * SC_BUF);
    float* outl = (float*)(smem + (c & 1) * SC_BUF + 21504);
    float myout = 0.f;
    f32x4 v4[4];
#pragma unroll
    for (int i = 0; i < 4; ++i) v4[i] = *(const f32x4*)(buf + 5120 + rowl * 16 + i * 4);
    f32x4 w4 = *(const f32x4*)(buf + j * 4), kd4 = *(const f32x4*)(buf + 1024 + j * 4), b4 = *(const f32x4*)(buf + 2048 + j * 4),
          kk4 = *(const f32x4*)(buf + 3072 + j * 4), r4 = *(const f32x4*)(buf + 4096 + j * 4);
    float dot;
    {
      f32x2 p = S01 * (f32x2){kk4[0], kk4[1]};
      p = S23 * (f32x2){kk4[2], kk4[3]} + p;
      dot = row16_sum(p[0] + p[1]);
    }
#pragma unroll
    for (int s = 0; s < 16; ++s) {
      f32x4 w4n, kd4n, b4n, kk4n, r4n;
      if (s < 15) {
        w4n = *(const f32x4*)(buf + (s + 1) * 64 + j * 4);
        kd4n = *(const f32x4*)(buf + 1024 + (s + 1) * 64 + j * 4);
        b4n = *(const f32x4*)(buf + 2048 + (s + 1) * 64 + j * 4);
        kk4n = *(const f32x4*)(buf + 3072 + (s + 1) * 64 + j * 4);
        r4n = *(const f32x4*)(buf + 4096 + (s + 1) * 64 + j * 4);
      }
      __builtin_amdgcn_sched_barrier(0);
      const float vf = v4[s >> 2][s & 3];
      const f32x2 t01 = S01 * (f32x2){w4[0], w4[1]} + (f32x2){kd4[0], kd4[1]} * vf;
      const f32x2 t23 = S23 * (f32x2){w4[2], w4[3]} + (f32x2){kd4[2], kd4[3]} * vf;
      S01 = t01 - (f32x2){b4[0], b4[1]} * dot;
      S23 = t23 - (f32x2){b4[2], b4[3]} * dot;
      f32x2 o = S01 * (f32x2){r4[0], r4[1]};
      o = S23 * (f32x2){r4[2], r4[3]} + o;
      float od = o[0] + o[1];
      if (s < 15) {
        f32x2 p = S01 * (f32x2){kk4n[0], kk4n[1]};
        p = S23 * (f32x2){kk4n[2], kk4n[3]} + p;
        float dn = p[0] + p[1];
        row16_sum2(dn, od);
        dot = dn;
        w4 = w4n; kd4 = kd4n; b4 = b4n; kk4 = kk4n; r4 = r4n;
      } else {
        od = row16_sum(od);
      }
      myout = (j == s) ? od : myout;
    }
    outl[j * 16 + rowl] = myout;
    if (c + 1 < nch) SC_STORE((c + 1) & 1)
    __syncthreads();
    if (!dry) __hip_atomic_fetch_add(ORW + SC_TOK(c) * 256, outl[rowl * 16 + j], __ATOMIC_RELAXED, __HIP_MEMORY_SCOPE_AGENT);
    if (c + 2 < nch) SC_LOAD(c + 2)
  }
#undef SC_TOK
#undef SC_LOAD
#undef SC_STORE
  if (seq < 16 && !dry) {
    f32x4 o; o[0] = S01[0]; o[1] = S01[1]; o[2] = S23[0]; o[3] = S23[1];
    *(f32x4*)(P.out + OUT_SR + (((((size_t)seq * 2 + l) * 2 + dir) * 4 + h) * 64 + row) * 64 + j * 4) = o;
  }
  __syncthreads();
}

__device__ __forceinline__ void fourier_tile(const Params& P, int item, unsigned char* smem) {
  int seq, mt, nt;
  if (item < 128) { seq = 16 + (item >> 6); mt = (item >> 1) & 31; nt = item & 1; }
  else { const int r = item - 128; seq = r >> 2; mt = (r >> 1) & 1; nt = r & 1; }
  const int start = seq < 16 ? seq * 256 : 4096 + (seq - 16) * 4096, L = seq < 16 ? 256 : 4096, sh = seq < 16 ? 4 : 0;
  const bf16_t* ZT = (const bf16_t*)(PWS + OFF_ZT);
  bf16_t* YS = (bf16_t*)(PWS + OFF_YS);
  f32x4 acc[4][4]; ACC_ZERO(acc);
  if (seq < 16) {
    gemm_acc<1, 4, 4>(acc, nullptr, 0, ZT + (size_t)(nt * 128) * NT + start, NT, smem, mt * 128, 255, 4, 0, 0);
    gemm_acc<1, 4, 4>(acc, nullptr, 0, ZT + (size_t)(256 + nt * 128) * NT + start, NT, smem, mt * 128, 255, 4, 3072, 0);
  } else {
#pragma unroll 1
    for (int pass = 0; pass < 8; ++pass) {
      const int nb = (pass & 3) * 1024, sn = pass >> 2;
      gemm_acc<1, 4, 16>(acc, nullptr, 0, ZT + (size_t)(sn * 256 + nt * 128) * NT + start + nb, NT, smem, mt * 128, 4095, 0, sn ? 3072 : 0, nb);
    }
  }
  const float scl = seq < 16 ? 0.0625f : 0.015625f;
  EPI_BEGIN(acc)
    uint4 pk; pk.x = pk2(v0[0] * scl, v0[1] * scl); pk.y = pk2(v0[2] * scl, v0[3] * scl); pk.z = pk2(v1[0] * scl, v1[1] * scl); pk.w = pk2(v1[2] * scl, v1[3] * scl);
    *(uint4*)(YS + (size_t)(start + mt * 128 + r) * 1024 + 256 + nt * 128 + c) = pk;
  EPI_END
}

#define CT 24
__device__ __forceinline__ void combine_tile(const Params& P, int l, int tile, unsigned char* smem) {
  const int tid = otid(), tok0 = tile * CT, col = tid;
  const bf16_t* U = (const bf16_t*)(PWS + OFF_U);
  bf16_t* YS = (bf16_t*)(PWS + OFF_YS);
  float* sg = (float*)smem;
  for (int i = tid; i < CT * 64; i += 256) sg[i] = sigmoidf_(bf2f(U[(size_t)(tok0 + (i >> 6)) * NU + UCG + (i & 63)]));
  __syncthreads();
  float gate[CT];
  {
    float wreg[64];
    const float* bg = P.in[I_BG] + (size_t)l * 64 * 256 + col;
#pragma unroll
    for (int r = 0; r < 64; ++r) wreg[r] = bg[r * 256];
#pragma unroll
    for (int tt = 0; tt < CT; ++tt) {
      float a0 = 0.f, a1 = 0.f;
#pragma unroll
      for (int r4 = 0; r4 < 16; ++r4) {
        const f32x4 x4 = *(const f32x4*)(sg + tt * 64 + r4 * 4);
        a0 += x4[0] * wreg[r4 * 4] + x4[2] * wreg[r4 * 4 + 2];
        a1 += x4[1] * wreg[r4 * 4 + 1] + x4[3] * wreg[r4 * 4 + 3];
      }
      gate[tt] = a0 + a1;
    }
  }
  const bf16_t* Rr = (const bf16_t*)(PWS + OFF_M + M_R);
  const bf16_t* Vv = (const bf16_t*)(PWS + OFF_M + M_V);
  const bf16_t* KD = (const bf16_t*)(PWS + OFF_M + M_KD);
  const float* ORW = (const float*)(PWS + OFF_ORW);
  const float* OG = (const float*)(PWS + OFF_M + M_OG);
  const float gn = P.in[I_GN][l * 256 + col], rk = P.in[I_RK][l * 256 + col], gnorm = P.in[I_GNORM][l * 256 + col];
#pragma unroll
  for (int tt = 0; tt < CT; ++tt) {
    const size_t o = (size_t)(tok0 + tt) * 256 + col;
    const float ov = ORW[o];
    const float mu = wave_sum(ov) * (1.f / 64.f);
    const float dv = ov - mu;
    const float var = wave_sum(dv * dv) * (1.f / 64.f);
    const float on = dv * rsqrtf(var + 64e-5f) * gn;
    const float r = bf2f(Rr[o]), v = bf2f(Vv[o]);
    const float kds = bf2f(KD[o]) + bf2f(KD[(size_t)NT * 256 + o]);
    const float bonus = wave_sum(r * kds * rk);
    const float yc = (on + bonus * v) * gate[tt];
    YS[(size_t)(tok0 + tt) * 1024 + 512 + col] = f2bf(yc);
    const float og = OG[o];
    const float ms = wave_sum(og * og) * (1.f / 64.f);
    const float go = bf2f(U[(size_t)(tok0 + tt) * NU + UGO + col]);
    const float yd = og * rsqrtf(ms + 1e-6f) * gnorm * (go * sigmoidf_(go));
    YS[(size_t)(tok0 + tt) * 1024 + 768 + col] = f2bf(yd);
  }
  __syncthreads();
}


#define OFF_BAR WS_END
#define XB_TMO      128
#define XB_XCNT(j)  (256  + 64 * (j))
#define XB_XSUB(j)  (1280 + 64 * (j))
#define XB_XGEN(j)  (2304 + 64 * (j))
#define XB_TOP      3328
#define XB_TOPGEN   3392
#define XCD_BAR_WORDS 3456
#define XB_SPIN_CAP (1u << 18)
#define LAS __attribute__((address_space(3)))

__device__ __forceinline__ unsigned xb_ld(unsigned* p)              { return __hip_atomic_load(p, __ATOMIC_RELAXED, __HIP_MEMORY_SCOPE_AGENT); }
__device__ __forceinline__ unsigned xb_add(unsigned* p, unsigned v) { return __hip_atomic_fetch_add(p, v, __ATOMIC_RELAXED, __HIP_MEMORY_SCOPE_AGENT); }
__device__ __forceinline__ unsigned xb_xcc_id() { return (unsigned)__builtin_amdgcn_s_getreg((3 << 11) | 20) & 0xFu; }
#define XB_SPIN(cond, bar) do { unsigned _sp = 0; while (cond) { __builtin_amdgcn_s_sleep(1); \
    if ((++_sp & 255u) == 0u) { if (xb_ld(&(bar)[XB_TMO])) break; if (_sp > XB_SPIN_CAP) { atomicAdd(&(bar)[XB_TMO], 1u); break; } } } } while (0)

struct XcdBarrier {
    unsigned* bar; unsigned x;
    volatile LAS unsigned* st;
};

__device__ __forceinline__ XcdBarrier xcd_barrier_post(unsigned* bar, volatile LAS unsigned* st) {
    XcdBarrier b; b.bar = bar; b.x = xb_xcc_id(); b.st = st;
    if (otid() == 0) st[2] = xb_add(&bar[XB_XCNT(b.x)], 1u);
    return b;
}
__device__ __forceinline__ void xcd_barrier_complete(unsigned* bar, unsigned x, unsigned& nloc, unsigned& nx) {
    const unsigned G = gridDim.x * gridDim.y * gridDim.z;
    unsigned sum, cnt, mine, sp = 0u;
    for (;;) {
        sum = 0u; cnt = 0u; mine = 0u;
#pragma unroll
        for (unsigned j = 0; j < 16; ++j) { const unsigned c = xb_ld(&bar[XB_XCNT(j)]); sum += c; cnt += (c > 0u) ? 1u : 0u; mine = (j == x) ? c : mine; }
        if (sum == G) break;
        __builtin_amdgcn_s_sleep(1);
        if ((++sp & 255u) == 0u) { if (xb_ld(&bar[XB_TMO])) break; if (sp > XB_SPIN_CAP) { atomicAdd(&bar[XB_TMO], 1u); break; } }
    }
    nloc = mine > 0u ? mine : 1u; nx = cnt > 0u ? cnt : 1u;
}

__device__ __forceinline__ void xcd_barrier(const XcdBarrier& b) {
    asm volatile("s_waitcnt vmcnt(0)" ::: "memory");
    __syncthreads();
    if (otid() == 0) {
        unsigned* bar = b.bar;
        __builtin_amdgcn_s_waitcnt(0);
        unsigned nloc = b.st[0], nx = b.st[1];
        if (nloc == 0u) { xcd_barrier_complete(bar, b.x, nloc, nx); b.st[0] = nloc; b.st[1] = nx; }
        const unsigned old = xb_add(&bar[XB_XSUB(b.x)], 1u);
        const unsigned gen = old / nloc;
        if (old + 1u == (gen + 1u) * nloc) {
            __builtin_amdgcn_fence(__ATOMIC_RELEASE, "agent");
            asm volatile("s_waitcnt vmcnt(0)" ::: "memory");
            const unsigned og = xb_add(&bar[XB_TOP], 1u);
            const unsigned tg = og / nx;
            if (og + 1u == (tg + 1u) * nx) xb_add(&bar[XB_TOPGEN], 1u);
            else XB_SPIN(xb_ld(&bar[XB_TOPGEN]) == tg, bar);
            __builtin_amdgcn_fence(__ATOMIC_ACQUIRE, "agent");
            xb_add(&bar[XB_XGEN(b.x)], 1u);
            asm volatile("s_waitcnt vmcnt(0)" ::: "memory");
        } else {
            XB_SPIN(xb_ld(&bar[XB_XGEN(b.x)]) == gen, bar);
            __builtin_amdgcn_fence(__ATOMIC_ACQUIRE, "agent");
            asm volatile("s_waitcnt vmcnt(0)" ::: "memory");
        }
    }
    __syncthreads();
}
#define gsync(P_, e_) xcd_barrier(xb)

#ifndef R_P0
#define R_P0 1
#endif
#ifndef R_NORM
#define R_NORM 1
#endif
#ifndef R_GEMM
#define R_GEMM 1
#endif
#ifndef R_PREP
#define R_PREP 1
#endif
#ifndef R_SCAN
#define R_SCAN 1
#endif
#ifndef R_FOUR
#define R_FOUR 1
#endif
#ifndef R_G2
#define R_G2 1
#endif
#define REP(n) for (int rep = 0; rep < 1; ++rep)
__global__ void __launch_bounds__(256, 2) mega(Params P) {
  extern __shared__ __attribute__((aligned(16))) unsigned char smem[];
  cg::grid_group grid = cg::this_grid();
  const int G = gridDim.x;
  unsigned epoch = 0;
  int zero = 0; asm volatile("" : "+s"(zero));
  volatile LAS unsigned* xst = (volatile LAS unsigned*)(LAS unsigned char*)(smem + LDS_BYTES - 16);
  if (otid() == 0) { xst[0] = 0u; xst[1] = 0u; }
  __syncthreads();
  XcdBarrier xb = xcd_barrier_post((unsigned*)(PWS + OFF_BAR), xst);
  grid.sync();
  REP(R_P0) {
    phase_mod(P, smem);
    __syncthreads();
    phase_table(P);
    {
      const int nb = G > 256 ? G - 192 : G;
      if (G > 256) { if ((int)blockIdx.x >= 192) phase_convert(P, 0, smem, blockIdx.x - 192, nb); }
      else phase_convert(P, 0, smem, blockIdx.x, nb);
    }
  }
  gsync(P, epoch);
  TL tl;
  {
    const unsigned nloc = xst[0], nx = xst[1], jl = xst[2];
    if (nx == 8u && xb.x < 8u && nloc > 0u) { tl.x = (int)xb.x; tl.j = (int)jl; tl.n = (int)nloc; }
    else { tl.x = blockIdx.x & 7; tl.j = blockIdx.x >> 3; tl.n = G >> 3; }
  }
#pragma unroll 1
  for (int l = 0; l < 2; ++l) {
    REP(R_NORM) {
      if (l == 1) phase_convert(P, 1, smem, blockIdx.x, G);
      phase_norm(P, l, 0);
    }
    gsync(P, epoch);
    REP(R_GEMM) phase_gemm1(P, smem, tl);
#ifdef DUP_GEMM
    phase_gemm1(P, smem, tl);
#endif
    gsync(P, epoch);
    if (G > 384 + 64) {
      if ((int)blockIdx.x < 384) prep_tile(P, l, blockIdx.x, smem);
      else for (int it = blockIdx.x - 384; it < 1536; it += G - 384) gla_g1(P, l, it, smem);
    } else {
      for (int it = blockIdx.x; it < 384 + 1536; it += G) {
        if (it < 384) prep_tile(P, l, it, smem); else gla_g1(P, l, it - 384, smem);
      }
    }
#ifdef DUP_PREP
    for (int it = blockIdx.x; it < 384; it += G) prep_tile(P, l, it, smem);
#endif
#ifdef DUP_G1
    for (int it = blockIdx.x + 384; it < 384 + 1536; it += G) gla_g1(P, l, it - 384, smem);
#endif
    gsync(P, epoch);
    {
      const bf16_t* tabg = (const bf16_t*)(PWS + OFF_TAB);
      bf16_t* tabl = (bf16_t*)(smem + LDS_TAB);
      for (int i = otid(); i < 4096; i += 256) tabl[i] = tabg[i];
      __syncthreads();
      if (G >= 256) {
        const int b = blockIdx.x;
        const bool is_scan = b < 128 && (b & 8) == 0;
        if (is_scan) rwkv_scan(P, l, (b >> 4) * 8 + (b & 7), false, smem);
        else {
          const int ob = b < 128 ? (b >> 4) * 8 + (b & 7) : b - 64;
          for (int it = 64 + ob; it < 576 + 192 + 768; it += G - 64) {
            if (it < 576) rwkv_scan(P, l, it, false, smem);
            else if (it < 768) fourier_tile(P, it - 576, smem);
            else gla_g2(P, l, it - 768, smem);
          }
        }
      } else {
        for (int it = blockIdx.x; it < 576 + 192 + 768; it += G) {
          if (it < 576) rwkv_scan(P, l, it, false, smem);
          else if (it < 768) fourier_tile(P, it - 576, smem);
          else gla_g2(P, l, it - 768, smem);
        }
      }
    }
    gsync(P, epoch);
    REP(R_PREP) for (int it = blockIdx.x; it < NT / CT; it += G) combine_tile(P, l, it, smem);
#ifdef DUP_COMB
    for (int it = blockIdx.x; it < 384; it += G) combine_tile(P, l, it, smem);
#endif
    gsync(P, epoch);
    REP(R_GEMM) phase_gemm_mlog(P, smem, tl);
#ifdef DUP_GEMM
    phase_gemm_mlog(P, smem, tl);
#endif
    gsync(P, epoch);
    REP(R_GEMM) phase_merge(P, smem, tl);
#ifdef DUP_GEMM
    phase_merge(P, smem, tl);
#endif
    gsync(P, epoch);
    REP(R_GEMM) phase_gemm_res(P, l, 0, smem, rep > 0, tl);
    gsync(P, epoch);
    REP(R_NORM) phase_norm(P, l, 1);
    gsync(P, epoch);
    REP(R_GEMM) phase_mlp_up(P, smem, tl);
#ifdef DUP_GEMM
    phase_mlp_up(P, smem, tl);
#endif
    gsync(P, epoch);
    REP(R_GEMM) phase_gemm_res(P, l, 1, smem, rep > 0, tl);
    gsync(P, epoch);
  }
#ifdef R_SYNC
  for (int i = 0; i < R_SYNC + zero; ++i) gsync(P, epoch);
#endif
  phase_norm(P, 0, 2);
}

extern "C" void kernel_launch(void* const* d_in, const int* in_sizes, int n_in, void* d_out, int out_size, void* d_ws, size_t ws_size,
                              hipStream_t stream) {
  static int grid_blocks = 0;
  if (!grid_blocks) {
    int dev = 0, cus = 0, per_cu = 0;
    hipGetDevice(&dev);
    hipDeviceGetAttribute(&cus, hipDeviceAttributeMultiprocessorCount, dev);
    hipFuncSetAttribute((const void*)mega, hipFuncAttributeMaxDynamicSharedMemorySize, LDS_BYTES);
    hipOccupancyMaxActiveBlocksPerMultiprocessor(&per_cu, (const void*)mega, 256, LDS_BYTES);
    per_cu = 2;
    grid_blocks = cus * per_cu;
    if (ws_size < WS_END) fprintf(stderr, "kernel_launch: workspace too small: %zu < %llu\n", ws_size, (unsigned long long)WS_END);
  }
  Params p{};
  for (int i = 0; i < 31; ++i) p.in[i] = (const float*)d_in[i];
  p.out = (float*)d_out;
  p.ws_ = (unsigned char*)d_ws;
  hipMemsetAsync((unsigned char*)d_ws + OFF_BAR, 0, XCD_BAR_WORDS * 4, stream);
  void* args[] = {&p};
  hipError_t e = hipLaunchCooperativeKernel((const void*)mega, dim3(grid_blocks), dim3(256), args, LDS_BYTES, stream);
  if (e != hipSuccess) fprintf(stderr, "cooperative launch failed: %s (grid %d)\n", hipGetErrorString(e), grid_blocks);
}
```

```cpp
#define TILE_STRIP 6
#include <hip/hip_runtime.h>
#include <hip/hip_cooperative_groups.h>
#include <cstdio>
#include <cstdint>
namespace cg = cooperative_groups;

typedef unsigned short bf16_t;
typedef short bf16x8 __attribute__((ext_vector_type(8)));
typedef float f32x4 __attribute__((ext_vector_type(4)));

#define NT 12288
#define DM 1024
#define NU 2176
#define NWIN 6784
#define DFF 4096
#define UP 0
#define UR 256
#define UK 512
#define UV 768
#define UCW 1024
#define UCA 1152
#define UCG 1216
#define UGQ 1280
#define UGK 1408
#define UGV 1536
#define UGO 1792
#define UCAL 2048

#define OFF_MOD 0ull
#define OFF_TAB 147456ull
#define OFF_WIN 155648ull
#define OFF_WB 14049280ull
#define OFF_WO 16146432ull
#define OFF_W1 18243584ull
#define OFF_W2 26632192ull
#define OFF_H 35020800ull
#define OFF_U 60186624ull
#define OFF_ZT 113664000ull
#define OFF_YS 126246912ull
#define OFF_ORW 151412736ull
#define OFF_M 163995648ull
#define WS_END 264658944ull
#define M_R 0ull
#define M_V 6291456ull
#define M_KK 12582912ull
#define M_KD 18874368ull
#define M_B 31457280ull
#define M_W 44040192ull
#define M_OG 69206016ull
#define M_GS 81788928ull

#define OUT_SR 12582912ull
#define OUT_SG 13631488ull

#define LDS_BYTES 74256
#define LDS_TAB 66048

struct Params {
  const float* in[31];
  float* out;
  unsigned char* ws_;
};
enum { I_XP = 0, I_XS, I_SRW, I_SGL, I_C, I_CCTX, I_ADAW, I_ADAB, I_N1G, I_N2G, I_WIN, I_POOLW, I_POOLS, I_MU, I_W0, I_BW,
       I_A0, I_BA, I_KKP, I_KA, I_BG, I_RK, I_GN, I_GAB, I_GABIAS, I_GNORM, I_WBR, I_WOUT, I_W1, I_W2, I_FG };

__device__ __forceinline__ bf16_t f2bf(float f) {
  unsigned u = __float_as_uint(f);
  u += 0x7fffu + ((u >> 16) & 1u);
  return (bf16_t)(u >> 16);
}
__device__ __forceinline__ float bf2f(bf16_t h) { return __uint_as_float(((unsigned)h) << 16); }
__device__ __forceinline__ unsigned pk2(float a, float b) { return (unsigned)f2bf(a) | ((unsigned)f2bf(b) << 16); }
__device__ __forceinline__ float bflo(unsigned u) { return __uint_as_float(u << 16); }
__device__ __forceinline__ float bfhi(unsigned u) { return __uint_as_float(u & 0xffff0000u); }
__device__ __forceinline__ float sigmoidf_(float x) { return __frcp_rn(1.f + __expf(-x)); }
__device__ __forceinline__ float row16_sum(float v);
__device__ __forceinline__ float wave_sum(float v) {
  v = row16_sum(v);
  const int iv = __builtin_bit_cast(int, v);
  const float s0 = __builtin_bit_cast(float, __builtin_amdgcn_readlane(iv, 0)), s1 = __builtin_bit_cast(float, __builtin_amdgcn_readlane(iv, 16));
  const float s2 = __builtin_bit_cast(float, __builtin_amdgcn_readlane(iv, 32)), s3 = __builtin_bit_cast(float, __builtin_amdgcn_readlane(iv, 48));
  return (s0 + s1) + (s2 + s3);
}
__device__ __forceinline__ float row16_sum(float v) {
  v += __builtin_bit_cast(float, __builtin_amdgcn_update_dpp(0, __builtin_bit_cast(int, v), 0x128, 0xf, 0xf, false));
  v += __builtin_bit_cast(float, __builtin_amdgcn_update_dpp(0, __builtin_bit_cast(int, v), 0x124, 0xf, 0xf, false));
  v += __builtin_bit_cast(float, __builtin_amdgcn_update_dpp(0, __builtin_bit_cast(int, v), 0x122, 0xf, 0xf, false));
  v += __builtin_bit_cast(float, __builtin_amdgcn_update_dpp(0, __builtin_bit_cast(int, v), 0x121, 0xf, 0xf, false));
  return v;
}
#define DPP_ADD(v_, ctrl_) v_ += __builtin_bit_cast(float, __builtin_amdgcn_update_dpp(0, __builtin_bit_cast(int, v_), ctrl_, 0xf, 0xf, false))
__device__ __forceinline__ void row16_sum2(float& a, float& b) {
  DPP_ADD(a, 0x128); DPP_ADD(b, 0x128); DPP_ADD(a, 0x124); DPP_ADD(b, 0x124); DPP_ADD(a, 0x122); DPP_ADD(b, 0x122); DPP_ADD(a, 0x121); DPP_ADD(b, 0x121);
}
__device__ __forceinline__ void seq_of_tok(int tok, int& start, int& L, int& ci) {
  if (tok < 4096) { start = tok & ~255; L = 256; ci = 0; }
  else { int b = (tok - 4096) >> 12; start = 4096 + (b << 12); L = 4096; ci = 1 + b; }
}

__device__ __forceinline__ size_t oz0() { size_t z = 0; asm volatile("" : "+s"(z)); return z; }
#define PWS (P.ws_ + oz0())
__device__ __forceinline__ int otid() { int t = threadIdx.x; asm volatile("" : "+v"(t)); return t; }
template <int AMODE, int NF, int NK>
__device__ __forceinline__ void gemm_acc(f32x4 (&acc)[4][NF], const bf16_t* __restrict__ A, int lda, const bf16_t* __restrict__ B, int ldb,
                                         unsigned char* smem, int k1base = 0, int Lmask = 0, int sh = 0, int ph = 0, int nbase = 0) {
  const int tid = otid(), lane = tid & 63, wid = tid >> 6, wr = wid >> 1, wc = wid & 1;
  bf16_t* sA = (bf16_t*)smem;
  bf16_t* sB = (bf16_t*)(smem + 32768);
  const bf16_t* tab = (const bf16_t*)(smem + LDS_TAB);
  uint4 ra0x, ra1x, ra2x, ra3x, rb0x, rb1x, rb2x, rb3x, ra0y, ra1y, ra2y, ra3y, rb0y, rb1y, rb2y, rb3y;
  const int row0 = tid >> 3, kc0 = tid & 7;
  const int soff = row0 * 64 + ((kc0 ^ ((row0 >> 1) & 7)) << 3);
  const int rho0 = (((row0 >> 2) & 1) << 4) | ((row0 >> 3) << 2) | (row0 & 3);
  const int soffB = rho0 * 64 + ((kc0 ^ ((rho0 >> 1) & 7)) << 3);
  const bf16_t* Ap = A + (size_t)row0 * lda + kc0 * 8;
  const bf16_t* Bp = B + (size_t)row0 * ldb + kc0 * 8;
#define GL1(r_, P_, ld_, i_, kt_) r_ = *(const uint4*)(P_ + (size_t)(32 * i_) * ld_ + (kt_) * 64);
#define GLOAD(X, kt) { if (AMODE == 0) { GL1(ra0##X, Ap, lda, 0, kt) GL1(ra1##X, Ap, lda, 1, kt) GL1(ra2##X, Ap, lda, 2, kt) GL1(ra3##X, Ap, lda, 3, kt) } \
    GL1(rb0##X, Bp, ldb, 0, kt) GL1(rb1##X, Bp, ldb, 1, kt) if (NF == 4) { GL1(rb2##X, Bp, ldb, 2, kt) GL1(rb3##X, Bp, ldb, 3, kt) } }
#define TABV(dst_) { const unsigned lo = tab[((idx << sh) + ph) & 4095]; idx = (idx + k1) & Lmask; const unsigned hi = tab[((idx << sh) + ph) & 4095]; idx = (idx + k1) & Lmask; dst_ = lo | (hi << 16); }
#define GEN1(r_, i_, kt_) { const int k1 = k1base + row0 + 32 * i_, n = nbase + (kt_) * 64 + kc0 * 8; int idx = (k1 * n) & Lmask; TABV(r_.x) TABV(r_.y) TABV(r_.z) TABV(r_.w) }
#define SSTORE(X, buf, kt) { if (AMODE == 1) { GEN1(ra0##X, 0, kt) GEN1(ra1##X, 1, kt) GEN1(ra2##X, 2, kt) GEN1(ra3##X, 3, kt) } \
    *(uint4*)(sA + (buf) * 8192 + soff) = ra0##X; *(uint4*)(sA + (buf) * 8192 + soff + 2048) = ra1##X; *(uint4*)(sA + (buf) * 8192 + soff + 4096) = ra2##X; *(uint4*)(sA + (buf) * 8192 + soff + 6144) = ra3##X; \
    *(uint4*)(sB + (buf) * 8192 + soffB) = rb0##X; *(uint4*)(sB + (buf) * 8192 + soffB + 2048) = rb1##X; \
    if (NF == 4) { *(uint4*)(sB + (buf) * 8192 + soffB + 4096) = rb2##X; *(uint4*)(sB + (buf) * 8192 + soffB + 6144) = rb3##X; } }
#define COMPUTE(buf) { \
    _Pragma("unroll") for (int ks = 0; ks < 2; ++ks) { \
      bf16x8 af[4], bfr[NF]; \
      const int q = ks * 4 + (lane >> 4); \
      _Pragma("unroll") for (int m = 0; m < 4; ++m) { const int r = wr * 64 + m * 16 + (lane & 15); af[m] = *(const bf16x8*)(sA + (buf) * 8192 + r * 64 + ((q ^ ((r >> 1) & 7)) << 3)); } \
      _Pragma("unroll") for (int n = 0; n < NF; ++n) { const int r = wc * (NF * 16) + n * 16 + (lane & 15); bfr[n] = *(const bf16x8*)(sB + (buf) * 8192 + r * 64 + ((q ^ ((r >> 1) & 7)) << 3)); } \
      _Pragma("unroll") for (int m = 0; m < 4; ++m) \
        _Pragma("unroll") for (int n = 0; n < NF; ++n) acc[m][n] = __builtin_amdgcn_mfma_f32_16x16x32_bf16(bfr[n], af[m], acc[m][n], 0, 0, 0); \
    } }
  static_assert(NK >= 4 && (NK & 1) == 0, "NK even, >= 4");
  GLOAD(x, 0)
  GLOAD(y, 1)
  SSTORE(x, 0, 0)
  __syncthreads();
#pragma unroll
  for (int kt = 0; kt < NK - 2; kt += 2) {
    GLOAD(x, kt + 2)
    COMPUTE(0)
    SSTORE(y, 1, kt + 1)
    __syncthreads();
    GLOAD(y, kt + 3)
    COMPUTE(1)
    SSTORE(x, 0, kt + 2)
    __syncthreads();
  }
  COMPUTE(0)
  SSTORE(y, 1, NK - 1)
  __syncthreads();
  COMPUTE(1)
  __syncthreads();
#undef GLOAD
#undef SSTORE
#undef COMPUTE
#undef GL1
#undef TABV
#undef GEN1
}
#define ACC_ZERO(a) ACC_ZERO_N(a, 4)
#define ACC_ZERO_N(a, NF_) _Pragma("unroll") for (int m_ = 0; m_ < 4; ++m_) _Pragma("unroll") for (int n_ = 0; n_ < NF_; ++n_) a[m_][n_] = (f32x4){0.f, 0.f, 0.f, 0.f}
#define EPI_BEGIN(a) EPI_BEGIN_N(a, 4)
#define EPI_BEGIN_N(a, NF_) { const int t_ = otid(), lane_ = t_ & 63, wid_ = t_ >> 6, wr_ = wid_ >> 1, wc_ = wid_ & 1; \
  _Pragma("unroll") for (int m_ = 0; m_ < 4; ++m_) _Pragma("unroll") for (int p_ = 0; p_ < NF_ / 2; ++p_) { \
    const int r = wr_ * 64 + m_ * 16 + (lane_ & 15), c = wc_ * (NF_ * 16) + p_ * 32 + (lane_ >> 4) * 8; f32x4& v0 = a[m_][2 * p_]; f32x4& v1 = a[m_][2 * p_ + 1];
#define EPI_END }}

__device__ __forceinline__ void phase_mod(const Params& P, unsigned char* smem) {
  float* sc = (float*)smem;
  float* part = (float*)(smem + 12288);
  const int tid = otid(), lane = tid & 63, w = tid >> 6;
  float* mod = (float*)(PWS + OFF_MOD);
  if (blockIdx.x >= 192) return;
  for (int i = tid; i < 3072; i += 256) {
    const int ci = i >> 10, k = i & 1023;
    const float c = ci == 0 ? P.in[I_CCTX][k] : P.in[I_C][(ci - 1) * 1024 + k];
    sc[i] = c * sigmoidf_(c);
  }
  __syncthreads();
  for (int item = blockIdx.x; item < 192; item += gridDim.x) {
    const int l = item / 96, cb = item % 96, col = cb * 64 + lane;
    const float* W = P.in[I_ADAW] + (size_t)l * 1024 * 6144 + col;
    float a0 = 0.f, a1 = 0.f, a2 = 0.f;
#pragma unroll 8
    for (int k = w * 256; k < w * 256 + 256; ++k) {
      const float wv = W[(size_t)k * 6144];
      a0 += sc[k] * wv; a1 += sc[1024 + k] * wv; a2 += sc[2048 + k] * wv;
    }
    part[(w * 3 + 0) * 64 + lane] = a0; part[(w * 3 + 1) * 64 + lane] = a1; part[(w * 3 + 2) * 64 + lane] = a2;
    __syncthreads();
    if (tid < 192) {
      const int ci = tid >> 6;
      const float s = part[(0 * 3 + ci) * 64 + lane] + part[(1 * 3 + ci) * 64 + lane] + part[(2 * 3 + ci) * 64 + lane] + part[(3 * 3 + ci) * 64 + lane];
      mod[(size_t)(l * 3 + ci) * 6144 + col] = s + P.in[I_ADAB][l * 6144 + col];
    }
    __syncthreads();
  }
}

__device__ __forceinline__ void conv_tile(const float* __restrict__ W, int N, int K, int k0, int scol0, int nvalid, bf16_t* __restrict__ dst, int drow0, float* t) {
  const int tid = otid();
#pragma unroll
  for (int i = 0; i < 16; ++i) {
    const int kk = (tid >> 6) + 4 * i, j = tid & 63;
    t[kk * 65 + j] = (j < nvalid) ? W[(size_t)(k0 + kk) * N + scol0 + j] : 0.f;
  }
  __syncthreads();
  {
    const int n = tid >> 2, kq = (tid & 3) * 16;
    uint4 o0, o1;
    const float* s = t + kq * 65 + n;
    o0.x = pk2(s[0], s[65]); o0.y = pk2(s[130], s[195]); o0.z = pk2(s[260], s[325]); o0.w = pk2(s[390], s[455]);
    s += 8 * 65;
    o1.x = pk2(s[0], s[65]); o1.y = pk2(s[130], s[195]); o1.z = pk2(s[260], s[325]); o1.w = pk2(s[390], s[455]);
    uint4* d = (uint4*)(dst + (size_t)(drow0 + n) * K + k0 + kq);
    d[0] = o0; d[1] = o1;
  }
  __syncthreads();
}
__device__ __forceinline__ void fold_tile(const float* __restrict__ W, int N, int K, int k0, int scol0, int sn, bf16_t* __restrict__ dst, int drow0, float* t, float* t2, const float* ctab) {
  const int tid = otid();
#pragma unroll
  for (int i = 0; i < 16; ++i) {
    const int kk = (tid >> 6) + 4 * i, j = tid & 63;
    t[kk * 65 + j] = W[(size_t)(k0 + kk) * N + scol0 + j];
  }
  __syncthreads();
  {
    const int j = tid & 63, kq = tid >> 6;
    float acc[16];
#pragma unroll
    for (int u = 0; u < 16; ++u) acc[u] = 0.f;
    for (int i = 0; i < 64; ++i) {
      const float tv = ctab[(i * j - (sn ? 16 : 0)) & 63];
#pragma unroll
      for (int u = 0; u < 16; ++u) acc[u] += t[(kq * 16 + u) * 65 + i] * tv;
    }
    const float scl = sn ? -0.125f : 0.125f;
#pragma unroll
    for (int u = 0; u < 16; ++u) t2[(kq * 16 + u) * 65 + j] = acc[u] * scl;
  }
  __syncthreads();
  {
    const int n = tid >> 2, kq = (tid & 3) * 16;
    uint4 o0, o1;
    const float* s = t2 + kq * 65 + n;
    o0.x = pk2(s[0], s[65]); o0.y = pk2(s[130], s[195]); o0.z = pk2(s[260], s[325]); o0.w = pk2(s[390], s[455]);
    s += 8 * 65;
    o1.x = pk2(s[0], s[65]); o1.y = pk2(s[130], s[195]); o1.z = pk2(s[260], s[325]); o1.w = pk2(s[390], s[455]);
    uint4* d = (uint4*)(dst + (size_t)(drow0 + n) * K + k0 + kq);
    d[0] = o0; d[1] = o1;
  }
  __syncthreads();
}

#define CONV_ITEMS 4256
__device__ __forceinline__ void phase_convert(const Params& P, int l, unsigned char* smem, int first, int stride) {
  float* t = (float*)smem;
  float* t2 = (float*)(smem + 16640);
  float* ctab = (float*)(smem + 33280);
  { const int tq = otid(); if (tq < 64) ctab[tq] = cosf(6.283185307179586f * (float)tq / 64.f); }
  __syncthreads();
  bf16_t* WIN = (bf16_t*)(PWS + OFF_WIN);
  for (int it = first; it < CONV_ITEMS; it += stride) {
    int r = it;
    if (r < 1696) {
      const int nt = r >> 4, kt = r & 15, np = nt * 64;
      const float* W = P.in[I_WIN] + (size_t)l * 1024 * 6432;
      if (np >= 2176 && np < 2688) {
        const int z = (np - 2176) >> 6, sn = z >> 2, g = z & 3;
        fold_tile(W, 6432, 1024, kt * 64, 256 + g * 64, sn, WIN, np, t, t2, ctab);
      } else {
        int scol, nvalid = 64;
        if (np < 256) scol = np;
        else if (np < 2080) { scol = np + 256; if (np + 64 > 2080) nvalid = 2080 - np; }
        else if (np < 2176) { scol = 0; nvalid = 0; }
        else scol = np - 352;
        conv_tile(W, 6432, 1024, kt * 64, scol, nvalid, WIN, np, t);
      }
      continue;
    }
    r -= 1696;
    if (r < 256) { conv_tile(P.in[I_WBR] + (size_t)l * 1024 * 1024, 1024, 1024, (r & 15) * 64, (r >> 4) * 64, 64, (bf16_t*)(PWS + OFF_WB), (r >> 4) * 64, t); continue; }
    r -= 256;
    if (r < 256) { conv_tile(P.in[I_WOUT] + (size_t)l * 1024 * 1024, 1024, 1024, (r & 15) * 64, (r >> 4) * 64, 64, (bf16_t*)(PWS + OFF_WO), (r >> 4) * 64, t); continue; }
    r -= 256;
    if (r < 1024) { conv_tile(P.in[I_W1] + (size_t)l * 1024 * 4096, 4096, 1024, (r & 15) * 64, (r >> 4) * 64, 64, (bf16_t*)(PWS + OFF_W1), (r >> 4) * 64, t); continue; }
    r -= 1024;
    conv_tile(P.in[I_W2] + (size_t)l * 4096 * 1024, 1024, 4096, (r & 63) * 64, (r >> 6) * 64, 64, (bf16_t*)(PWS + OFF_W2), (r >> 6) * 64, t);
  }
}
__device__ __forceinline__ void phase_table(const Params& P) {
  if (blockIdx.x == gridDim.x - 1) {
    bf16_t* tab = (bf16_t*)(PWS + OFF_TAB);
    for (int i = otid(); i < 4096; i += 256) tab[i] = f2bf(cosf(6.283185307179586f * (float)i / 4096.f));
  }
}

__device__ __forceinline__ void phase_norm(const Params& P, int l, int which) {
  const int tid = otid(), lane = tid & 63, gw = blockIdx.x * 4 + (tid >> 6), nw = gridDim.x * 4;
  const float* mod = (const float*)(PWS + OFF_MOD);
  bf16_t* H = (bf16_t*)(PWS + OFF_H);
  float omega[4] = {0.f, 0.f, 0.f, 0.f};
  if (which == 0 && l == 0) {
#pragma unroll
    for (int e = 0; e < 4; ++e) omega[e] = 1.0f / powf(10000.0f, (float)(lane * 4 + e) / 256.0f);
  }
  for (int tok = gw; tok < NT; tok += nw) {
    int start, L, ci; seq_of_tok(tok, start, L, ci);
    float* xr = P.out + (size_t)tok * 1024;
    f32x4 v[4];
    if (which == 0 && l == 0) {
      const float* src = tok < 4096 ? P.in[I_XP] + (size_t)tok * 1024 : P.in[I_XS] + (size_t)(tok - 4096) * 1024;
      const int n = tok - start;
#pragma unroll
      for (int j = 0; j < 4; ++j) {
        v[j] = *(const f32x4*)(src + j * 256 + lane * 4);
        if (tok >= 4096) {
          const float pos = (j < 2) ? (float)(n >> 6) : (float)(n & 63);
#pragma unroll
          for (int e = 0; e < 4; ++e) {
            const float ang = pos * omega[e];
            v[j][e] += (j & 1) ? cosf(ang) : sinf(ang);
          }
        }
        *(f32x4*)(xr + j * 256 + lane * 4) = v[j];
      }
    } else {
#pragma unroll
      for (int j = 0; j < 4; ++j) v[j] = *(const f32x4*)(xr + j * 256 + lane * 4);
    }
    float ss = 0.f;
#pragma unroll
    for (int j = 0; j < 4; ++j) ss += v[j][0] * v[j][0] + v[j][1] * v[j][1] + v[j][2] * v[j][2] + v[j][3] * v[j][3];
    ss = wave_sum(ss);
    const float rs = rsqrtf(ss * (1.f / 1024.f) + 1e-6f);
    if (which == 2) {
#pragma unroll
      for (int j = 0; j < 4; ++j) {
        const f32x4 g = *(const f32x4*)(P.in[I_FG] + j * 256 + lane * 4);
        f32x4 o;
#pragma unroll
        for (int e = 0; e < 4; ++e) o[e] = v[j][e] * rs * g[e];
        *(f32x4*)(xr + j * 256 + lane * 4) = o;
      }
    } else {
      const float* gsrc = (which == 0 ? P.in[I_N1G] : P.in[I_N2G]) + l * 1024;
      const float* mrow = mod + (size_t)(l * 3 + ci) * 6144 + (which == 0 ? 0 : 3072);
#pragma unroll
      for (int j = 0; j < 4; ++j) {
        const int c0 = j * 256 + lane * 4;
        const f32x4 g = *(const f32x4*)(gsrc + c0), shv = *(const f32x4*)(mrow + c0), scv = *(const f32x4*)(mrow + 1024 + c0);
        float o[4];
#pragma unroll
        for (int e = 0; e < 4; ++e) o[e] = v[j][e] * rs * g[e] * (1.f + scv[e]) + shv[e];
        uint2 pk; pk.x = pk2(o[0], o[1]); pk.y = pk2(o[2], o[3]);
        *(uint2*)(H + (size_t)tok * 1024 + c0) = pk;
      }
    }
  }
}

struct TL { int x, j, n; };
#define TILE_LOOP(NTN_) for (int q_ = tl.j, x_ = tl.x, nl_ = tl.n, NTN__ = (NTN_); q_ < 12 * (NTN_); q_ += nl_)
#ifdef TILE_STRIP
#define TILE_MT (12 * x_ + (q_ / (TILE_STRIP * NTN__)) * TILE_STRIP + q_ % TILE_STRIP)
#define TILE_NT ((q_ % (TILE_STRIP * NTN__)) / TILE_STRIP)
#else
#define TILE_MT (12 * x_ + q_ % 12)
#define TILE_NT (q_ / 12)
#endif
__device__ __forceinline__ void phase_gemm1(const Params& P, unsigned char* smem, const TL& tl) {
  const bf16_t* H = (const bf16_t*)(PWS + OFF_H);
  const bf16_t* WIN = (const bf16_t*)(PWS + OFF_WIN);
  bf16_t* U = (bf16_t*)(PWS + OFF_U);
  bf16_t* ZT = (bf16_t*)(PWS + OFF_ZT);
  TILE_LOOP(21) {
    const int mt = TILE_MT, nt = TILE_NT, m0 = mt * 128;
    f32x4 acc[4][4]; ACC_ZERO(acc);
    if (nt < 17) {
      gemm_acc<0, 4, 16>(acc, H + (size_t)m0 * 1024, 1024, WIN + (size_t)nt * 128 * 1024, 1024, smem);
      EPI_BEGIN(acc)
        uint4 pk; pk.x = pk2(v0[0], v0[1]); pk.y = pk2(v0[2], v0[3]); pk.z = pk2(v1[0], v1[1]); pk.w = pk2(v1[2], v1[3]);
        *(uint4*)(U + (size_t)(m0 + r) * NU + nt * 128 + c) = pk;
      EPI_END
    } else {
      const int z0 = (nt - 17) * 128;
      gemm_acc<0, 4, 16>(acc, WIN + (size_t)(2176 + z0) * 1024, 1024, H + (size_t)m0 * 1024, 1024, smem);
      EPI_BEGIN(acc)
        uint4 pk; pk.x = pk2(v0[0], v0[1]); pk.y = pk2(v0[2], v0[3]); pk.z = pk2(v1[0], v1[1]); pk.w = pk2(v1[2], v1[3]);
        *(uint4*)(ZT + (size_t)(z0 + r) * NT + m0 + c) = pk;
      EPI_END
    }
  }
}
__device__ __forceinline__ void phase_gemm_mlog(const Params& P, unsigned char* smem, const TL& tl) {
  const bf16_t* H = (const bf16_t*)(PWS + OFF_H);
  const bf16_t* WIN = (const bf16_t*)(PWS + OFF_WIN);
  bf16_t* Mg = (bf16_t*)(PWS + OFF_M);
  TILE_LOOP(32) {
    const int mt = TILE_MT, nt = TILE_NT, m0 = mt * 128;
    f32x4 acc[4][4]; ACC_ZERO(acc);
    gemm_acc<0, 4, 16>(acc, H + (size_t)m0 * 1024, 1024, WIN + (size_t)(2688 + nt * 128) * 1024, 1024, smem);
    EPI_BEGIN(acc)
      uint4 pk; pk.x = pk2(v0[0], v0[1]); pk.y = pk2(v0[2], v0[3]); pk.z = pk2(v1[0], v1[1]); pk.w = pk2(v1[2], v1[3]);
      *(uint4*)(Mg + (size_t)(m0 + r) * 4096 + nt * 128 + c) = pk;
    EPI_END
  }
}
__device__ __forceinline__ void phase_merge(const Params& P, unsigned char* smem, const TL& tl) {
  const bf16_t* YS = (const bf16_t*)(PWS + OFF_YS);
  const bf16_t* WB = (const bf16_t*)(PWS + OFF_WB);
  const bf16_t* Mg = (const bf16_t*)(PWS + OFF_M);
  bf16_t* MG = (bf16_t*)(PWS + OFF_U);
  TILE_LOOP(16) {
    const int mt = TILE_MT, nt = TILE_NT, m0 = mt * 128, n0 = nt * 64;
    f32x4 macc[4][2]; ACC_ZERO_N(macc, 2);
    const int t_ = otid(), lane_ = t_ & 63, wid_ = t_ >> 6, wr_ = wid_ >> 1, wc_ = wid_ & 1;
    const bf16_t* gp = Mg + (size_t)(m0 + wr_ * 64 + (lane_ & 15)) * 4096 + n0 + wc_ * 32 + (lane_ >> 4) * 8;
#define MROW(m, gX) { const uint4 gv = gX; \
      macc[m][0][0] += sigmoidf_(bflo(gv.x)) * acc[m][0][0]; macc[m][0][1] += sigmoidf_(bfhi(gv.x)) * acc[m][0][1]; \
      macc[m][0][2] += sigmoidf_(bflo(gv.y)) * acc[m][0][2]; macc[m][0][3] += sigmoidf_(bfhi(gv.y)) * acc[m][0][3]; \
      macc[m][1][0] += sigmoidf_(bflo(gv.z)) * acc[m][1][0]; macc[m][1][1] += sigmoidf_(bfhi(gv.z)) * acc[m][1][1]; \
      macc[m][1][2] += sigmoidf_(bflo(gv.w)) * acc[m][1][2]; macc[m][1][3] += sigmoidf_(bfhi(gv.w)) * acc[m][1][3]; }
#pragma unroll 1
    for (int i = 0; i < 4; ++i) {
      f32x4 acc[4][2]; ACC_ZERO_N(acc, 2);
      const uint4 g0 = *(const uint4*)(gp + i * 1024), g1 = *(const uint4*)(gp + (size_t)16 * 4096 + i * 1024),
                  g2 = *(const uint4*)(gp + (size_t)32 * 4096 + i * 1024), g3 = *(const uint4*)(gp + (size_t)48 * 4096 + i * 1024);
      gemm_acc<0, 2, 4>(acc, YS + (size_t)m0 * 1024 + i * 256, 1024, WB + (size_t)n0 * 1024 + i * 256, 1024, smem);
      MROW(0, g0) MROW(1, g1) MROW(2, g2) MROW(3, g3)
    }
#undef MROW
    EPI_BEGIN_N(macc, 2)
      uint4 pk; pk.x = pk2(v0[0], v0[1]); pk.y = pk2(v0[2], v0[3]); pk.z = pk2(v1[0], v1[1]); pk.w = pk2(v1[2], v1[3]);
      *(uint4*)(MG + (size_t)(m0 + r) * 1024 + n0 + c) = pk;
    EPI_END
  }
}
__device__ __forceinline__ void phase_gemm_res(const Params& P, int l, int which, unsigned char* smem, bool dry, const TL& tl) {
  const bf16_t* A = (const bf16_t*)(PWS + (which == 0 ? OFF_U : OFF_M));
  const bf16_t* W = (const bf16_t*)(PWS + (which == 0 ? OFF_WO : OFF_W2));
  const int K = which == 0 ? 1024 : 4096;
  const float* mod = (const float*)(PWS + OFF_MOD);
  TILE_LOOP(16) {
    const int mt = TILE_MT, nt = TILE_NT, m0 = mt * 128, n0 = nt * 64;
    int start, L, ci; seq_of_tok(m0, start, L, ci);
    const float* gate = mod + (size_t)(l * 3 + ci) * 6144 + (which == 0 ? 2048 : 5120);
    f32x4 acc[4][2]; ACC_ZERO_N(acc, 2);
    #pragma unroll 1
    for (int kc = 0; kc < K; kc += 1024) gemm_acc<0, 2, 16>(acc, A + (size_t)m0 * K + kc, K, W + (size_t)n0 * K + kc, K, smem);
    EPI_BEGIN_N(acc, 2)
      float* xp = P.out + (size_t)(m0 + r) * 1024 + n0 + c;
      const f32x4 g0 = *(const f32x4*)(gate + n0 + c), g1 = *(const f32x4*)(gate + n0 + c + 4);
      f32x4 x0 = *(const f32x4*)xp, x1 = *(const f32x4*)(xp + 4);
      x0[0] += g0[0] * v0[0]; x0[1] += g0[1] * v0[1]; x0[2] += g0[2] * v0[2]; x0[3] += g0[3] * v0[3];
      x1[0] += g1[0] * v1[0]; x1[1] += g1[1] * v1[1]; x1[2] += g1[2] * v1[2]; x1[3] += g1[3] * v1[3];
      if (!dry) { *(f32x4*)xp = x0; *(f32x4*)(xp + 4) = x1; }
    EPI_END
  }
}
__device__ __forceinline__ void phase_mlp_up(const Params& P, unsigned char* smem, const TL& tl) {
  const bf16_t* H = (const bf16_t*)(PWS + OFF_H);
  const bf16_t* W1 = (const bf16_t*)(PWS + OFF_W1);
  bf16_t* HID = (bf16_t*)(PWS + OFF_M);
  TILE_LOOP(32) {
    const int mt = TILE_MT, nt = TILE_NT, m0 = mt * 128;
    f32x4 acc[4][4]; ACC_ZERO(acc);
    gemm_acc<0, 4, 16>(acc, H + (size_t)m0 * 1024, 1024, W1 + (size_t)nt * 128 * 1024, 1024, smem);
    EPI_BEGIN(acc)
      float o[8];
#pragma unroll
      for (int e = 0; e < 4; ++e) { const float a = fmaxf(v0[e], 0.f), b = fmaxf(v1[e], 0.f); o[e] = a * a; o[4 + e] = b * b; }
      uint4 pk; pk.x = pk2(o[0], o[1]); pk.y = pk2(o[2], o[3]); pk.z = pk2(o[4], o[5]); pk.w = pk2(o[6], o[7]);
      *(uint4*)(HID + (size_t)(m0 + r) * 4096 + nt * 128 + c) = pk;
    EPI_END
  }
}

__device__ __forceinline__ void pool_tile(const Params& P, int l, int tile, unsigned char* smem) {
  const int tid = otid(), tok0 = tile * 32;
  int start, L, ci; seq_of_tok(tok0, start, L, ci);
  const bf16_t* U = (const bf16_t*)(PWS + OFF_U);
  bf16_t* YS = (bf16_t*)(PWS + OFF_YS);
  float* pl = (float*)smem;
  bf16_t* zw = (bf16_t*)(smem + 32768);
  float* tw = (float*)(smem + 32768);
  float* ca = (float*)(smem + 49152);
  const int col = tid, g = col >> 6;
#pragma unroll
  for (int i = 0; i < 6; ++i) {
    const int c = tid + 256 * i;
    if (c < 47 * 32) {
      const int rr = c >> 5, cc = (c & 31) * 8, t = tok0 - 8 + rr - start;
      uint4 v = make_uint4(0u, 0u, 0u, 0u);
      if (t >= 0 && t < L) v = *(const uint4*)(U + (size_t)(start + t) * NU + UP + cc);
      *(uint4*)(zw + rr * 256 + cc) = v;
    }
  }
  __syncthreads();
  {
    const int half = 1 << g, win = 2 << g;
#pragma unroll 4
    for (int tt = 0; tt < 32; ++tt) {
      const int t = tok0 + tt - start;
      const int lo = max(t - half, 0), hi = min(t + half - 1, L - 1);
      float s = 0.f;
      const bf16_t* zp = zw + (tt + 8 - half) * 256 + col;
      for (int p = 0; p < win; ++p) s += bf2f(zp[p * 256]);
      pl[tt * 256 + col] = s / (float)(hi - lo + 1) - bf2f(zw[(tt + 8) * 256 + col]);
    }
  }
  __syncthreads();
  {
    float wreg[64];
    const float* pw = P.in[I_POOLW] + (size_t)(l * 4 + g) * 4096 + (col & 63);
#pragma unroll
    for (int cc = 0; cc < 64; ++cc) wreg[cc] = pw[cc * 64];
    const float ps = P.in[I_POOLS][l * 256 + col];
#pragma unroll 2
    for (int tt = 0; tt < 32; ++tt) {
      float a0 = 0.f, a1 = 0.f;
#pragma unroll
      for (int c4 = 0; c4 < 16; ++c4) {
        const f32x4 p4 = *(const f32x4*)(pl + tt * 256 + g * 64 + c4 * 4);
        a0 += p4[0] * wreg[c4 * 4] + p4[2] * wreg[c4 * 4 + 2];
        a1 += p4[1] * wreg[c4 * 4 + 1] + p4[3] * wreg[c4 * 4 + 3];
      }
      YS[(size_t)(tok0 + tt) * 1024 + col] = f2bf((a0 + a1) * ps);
    }
  }
  __syncthreads();
}
__device__ __forceinline__ void prep_tile(const Params& P, int l, int tile, unsigned char* smem) {
  const int tid = otid(), tok0 = tile * 32;
  int start, L, ci; seq_of_tok(tok0, start, L, ci);
  const bf16_t* U = (const bf16_t*)(PWS + OFF_U);
  bf16_t* YS = (bf16_t*)(PWS + OFF_YS);
  float* pl = (float*)smem;
  bf16_t* zw = (bf16_t*)(smem + 32768);
  float* tw = (float*)(smem + 32768);
  float* ca = (float*)(smem + 49152);
  const int col = tid, g = col >> 6;
#pragma unroll
  for (int i = 0; i < 3; ++i) {
    const int c = tid + 256 * i, tt = c / 24, j8 = (c % 24) * 8;
    const uint4 v = *(const uint4*)(U + (size_t)(tok0 + tt) * NU + UCW + j8);
    const unsigned w4[4] = {v.x, v.y, v.z, v.w};
#pragma unroll
    for (int e2 = 0; e2 < 4; ++e2) {
      const float x0 = bflo(w4[e2]), x1 = bfhi(w4[e2]);
      const int jj = j8 + 2 * e2;
      if (jj < 128) { tw[tt * 128 + jj] = 1.f - 2.f * __frcp_rn(1.f + __expf(2.f * x0)); tw[tt * 128 + jj + 1] = 1.f - 2.f * __frcp_rn(1.f + __expf(2.f * x1)); }
      else { ca[tt * 64 + jj - 128] = x0; ca[tt * 64 + jj - 127] = x1; }
    }
  }
  __syncthreads();
  float* Wd = (float*)(PWS + OFF_M + M_W);
  float aF[32], aB[32];
#pragma unroll 1
  for (int dir = 0; dir < 2; ++dir) {
    {
      float wreg[64];
      const float* bw = P.in[I_BW] + (size_t)(l * 2 + dir) * 64 * 256 + col;
#pragma unroll
      for (int r = 0; r < 64; ++r) wreg[r] = bw[r * 256];
      const float w0 = P.in[I_W0][(l * 2 + dir) * 256 + col];
#pragma unroll 2
      for (int tt = 0; tt < 32; ++tt) {
        float a0 = w0, a1 = 0.f;
#pragma unroll
        for (int r4 = 0; r4 < 16; ++r4) {
          const f32x4 x4 = *(const f32x4*)(tw + tt * 128 + dir * 64 + r4 * 4);
          a0 += x4[0] * wreg[r4 * 4] + x4[2] * wreg[r4 * 4 + 2];
          a1 += x4[1] * wreg[r4 * 4 + 1] + x4[3] * wreg[r4 * 4 + 3];
        }
        Wd[((size_t)dir * NT + tok0 + tt) * 256 + col] = __expf(-0.606531f * sigmoidf_(a0 + a1));
      }
    }
    {
      float wreg[32];
      const float* ba = P.in[I_BA] + (size_t)(l * 2 + dir) * 32 * 256 + col;
#pragma unroll
      for (int r = 0; r < 32; ++r) wreg[r] = ba[r * 256];
      const float a0c = P.in[I_A0][(l * 2 + dir) * 256 + col];
#pragma unroll
      for (int tt = 0; tt < 32; ++tt) {
        float a0 = a0c, a1 = 0.f;
#pragma unroll
        for (int r4 = 0; r4 < 8; ++r4) {
          const f32x4 x4 = *(const f32x4*)(ca + tt * 64 + dir * 32 + r4 * 4);
          a0 += x4[0] * wreg[r4 * 4] + x4[2] * wreg[r4 * 4 + 2];
          a1 += x4[1] * wreg[r4 * 4 + 1] + x4[3] * wreg[r4 * 4 + 3];
        }
        const float a = sigmoidf_(a0 + a1);
        if (dir == 0) aF[tt] = a; else aB[tt] = a;
      }
    }
  }
  {
    bf16_t* Rr = (bf16_t*)(PWS + OFF_M + M_R);
    bf16_t* Vv = (bf16_t*)(PWS + OFF_M + M_V);
    bf16_t* KKn = (bf16_t*)(PWS + OFF_M + M_KK);
    bf16_t* KD = (bf16_t*)(PWS + OFF_M + M_KD);
    bf16_t* Bb = (bf16_t*)(PWS + OFF_M + M_B);
    float* ORW = (float*)(PWS + OFF_ORW);
    const float mur = P.in[I_MU][l * 768 + col], muk = P.in[I_MU][l * 768 + 256 + col], muv = P.in[I_MU][l * 768 + 512 + col];
    const float kkp = P.in[I_KKP][l * 256 + col], ka = P.in[I_KA][l * 256 + col];
#pragma unroll
    for (int tt = 0; tt < 32; ++tt) {
      const int tok = tok0 + tt, t = tok - start;
      const bf16_t* u0 = U + (size_t)tok * NU;
      const float zr = bf2f(u0[UR + col]), zk = bf2f(u0[UK + col]), zv = bf2f(u0[UV + col]);
      float pr = 0.f, pk = 0.f, pv = 0.f, nr = 0.f, nk = 0.f, nv = 0.f;
      if (t > 0) { pr = bf2f(u0[UR + col - NU]); pk = bf2f(u0[UK + col - NU]); pv = bf2f(u0[UV + col - NU]); }
      if (t < L - 1) { nr = bf2f(u0[UR + col + NU]); nk = bf2f(u0[UK + col + NU]); nv = bf2f(u0[UV + col + NU]); }
      const float r = zr + mur * (0.5f * (pr + nr) - zr);
      const float k = zk + muk * (0.5f * (pk + nk) - zk);
      const float v = zv + muv * (0.5f * (pv + nv) - zv);
      float kk = k * kkp;
      const float ss = wave_sum(kk * kk);
      kk *= rsqrtf(ss + 1e-6f);
      const size_t o = (size_t)tok * 256 + col;
      Rr[o] = f2bf(r); Vv[o] = f2bf(v); KKn[o] = f2bf(kk);
      KD[o] = f2bf(k * (1.f + (aF[tt] - 1.f) * ka)); KD[(size_t)NT * 256 + o] = f2bf(k * (1.f + (aB[tt] - 1.f) * ka));
      Bb[o] = f2bf(kk * aF[tt]); Bb[(size_t)NT * 256 + o] = f2bf(kk * aB[tt]);
      ORW[o] = 0.f;
    }
  }
  __syncthreads();
}

__device__ __forceinline__ void gla_bcum(const Params& P, int l, int dir, int h, int c0, float* gs) {
  const int tid = otid();
  const bf16_t* U = (const bf16_t*)(PWS + OFF_U);
  {
    const int pp = tid >> 2, dq = tid & 3, tok = dir ? c0 + 63 - pp : c0 + pp;
    const uint4* cp = (const uint4*)(U + (size_t)tok * NU + UCAL + dir * 16);
    const uint4 c0v = cp[0], c1v = cp[1];
    float cal[16];
    cal[0] = bflo(c0v.x); cal[1] = bfhi(c0v.x); cal[2] = bflo(c0v.y); cal[3] = bfhi(c0v.y); cal[4] = bflo(c0v.z); cal[5] = bfhi(c0v.z); cal[6] = bflo(c0v.w); cal[7] = bfhi(c0v.w);
    cal[8] = bflo(c1v.x); cal[9] = bfhi(c1v.x); cal[10] = bflo(c1v.y); cal[11] = bfhi(c1v.y); cal[12] = bflo(c1v.z); cal[13] = bfhi(c1v.z); cal[14] = bflo(c1v.w); cal[15] = bfhi(c1v.w);
    const float* ab = P.in[I_GAB] + (size_t)(l * 2 + dir) * 16 * 128 + h * 32 + dq * 8;
    const float* bias = P.in[I_GABIAS] + (l * 2 + dir) * 128 + h * 32 + dq * 8;
#pragma unroll
    for (int dd = 0; dd < 8; ++dd) {
      float x = bias[dd];
#pragma unroll
      for (int r = 0; r < 16; ++r) x += cal[r] * ab[r * 128 + dd];
      const float ls = fminf(x, 0.f) - __logf(1.f + __expf(-fabsf(x)));
      gs[pp * 32 + dq * 8 + dd] = ls * (1.f / 16.f);
    }
  }
  __syncthreads();
  {
    float* segs = gs + 10240;
    const int d = tid & 31, sg_ = tid >> 5;
    float v[8], run = 0.f;
#pragma unroll
    for (int i = 0; i < 8; ++i) { run += gs[(sg_ * 8 + i) * 32 + d]; v[i] = run; }
    segs[sg_ * 32 + d] = run;
    __syncthreads();
    float off = 0.f;
#pragma unroll
    for (int s2 = 0; s2 < 7; ++s2) off += (s2 < sg_) ? segs[s2 * 32 + d] : 0.f;
#pragma unroll
    for (int i = 0; i < 8; ++i) gs[(sg_ * 8 + i) * 32 + d] = v[i] + off;
  }
  __syncthreads();
}
__device__ __forceinline__ void gla_g1(const Params& P, int l, int item, unsigned char* smem) {
  const int tid = otid();
  const int dir = item & 1, h = (item >> 1) & 3, cgi = item >> 3, c0 = cgi * 64;
  const bf16_t* U = (const bf16_t*)(PWS + OFF_U);
  float* gs = (float*)smem;
  float* kt = (float*)(smem + 8192);
  float* vs = (float*)(smem + 16384);
  gla_bcum(P, l, dir, h, c0, gs);
  {
    const int pp = tid >> 2, q4 = tid & 3, tok = dir ? c0 + 63 - pp : c0 + pp;
    const uint4 kv = *(const uint4*)(U + (size_t)tok * NU + UGK + h * 32 + q4 * 8);
    const unsigned kw[4] = {kv.x, kv.y, kv.z, kv.w};
#pragma unroll
    for (int i = 0; i < 4; ++i) {
      const int d = q4 * 8 + 2 * i;
      kt[pp * 32 + d] = bflo(kw[i]) * __expf(gs[63 * 32 + d] - gs[pp * 32 + d]);
      kt[pp * 32 + d + 1] = bfhi(kw[i]) * __expf(gs[63 * 32 + d + 1] - gs[pp * 32 + d + 1]);
    }
    const uint4* vp = (const uint4*)(U + (size_t)tok * NU + UGV + h * 64 + q4 * 16);
    const uint4 v0 = vp[0], v1 = vp[1];
    const unsigned vw[8] = {v0.x, v0.y, v0.z, v0.w, v1.x, v1.y, v1.z, v1.w};
#pragma unroll
    for (int i = 0; i < 8; ++i) { vs[pp * 64 + q4 * 16 + 2 * i] = bflo(vw[i]); vs[pp * 64 + q4 * 16 + 2 * i + 1] = bfhi(vw[i]); }
  }
  __syncthreads();
  {
    const int e = tid & 63, dq = tid >> 6;
    float acc[8];
#pragma unroll
    for (int dd = 0; dd < 8; ++dd) acc[dd] = 0.f;
    for (int pp = 0; pp < 64; ++pp) {
      const float vv = vs[pp * 64 + e];
#pragma unroll
      for (int dd = 0; dd < 8; ++dd) acc[dd] += kt[pp * 32 + dq * 8 + dd] * vv;
    }
    float* S = (float*)(PWS + OFF_M + M_GS) + (size_t)item * 2080;
#pragma unroll
    for (int dd = 0; dd < 8; ++dd) S[(dq * 8 + dd) * 64 + e] = acc[dd];
    if (tid < 32) S[2048 + tid] = __expf(gs[63 * 32 + tid]);
  }
  __syncthreads();
}
__device__ __forceinline__ void gla_g2(const Params& P, int l, int item, unsigned char* smem) {
  const int tid = otid();
  const int h = item & 3, cgi = item >> 2, c0 = cgi * 64;
  int start, L, ci; seq_of_tok(c0, start, L, ci);
  const int cfirst = start >> 6, nc = L >> 6;
  const bf16_t* U = (const bf16_t*)(PWS + OFF_U);
  const float* GS = (const float*)(PWS + OFF_M + M_GS);
  float* gs = (float*)smem;
  float* qt = (float*)(smem + 8192);
  float* kt = (float*)(smem + 16384);
  float* vs = (float*)(smem + 24576);
  float* att = (float*)(smem + 40960);
  float* Sp = (float*)(smem + 57600);
  const int e = tid & 63, pq = tid >> 6;
  float oacc[16];
#pragma unroll
  for (int i = 0; i < 16; ++i) oacc[i] = 0.f;
#pragma unroll 1
  for (int dir = 0; dir < 2; ++dir) {
    gla_bcum(P, l, dir, h, c0, gs);
    {
      float S[8];
      if (ci == 0) {
#pragma unroll
        for (int dd = 0; dd < 8; ++dd) S[dd] = 0.f;
      } else {
        const float* s0 = P.in[I_SGL] + ((((size_t)(ci - 1) * 2 + l) * 2 + dir) * 4 + h) * 2048;
#pragma unroll
        for (int dd = 0; dd < 8; ++dd) S[dd] = s0[(pq * 8 + dd) * 64 + e];
      }
      if (dir == 0) {
        for (int j = cfirst; j < cgi; ++j) {
          const float* sj = GS + (size_t)((j * 4 + h) * 2 + 0) * 2080;
#pragma unroll
          for (int dd = 0; dd < 8; ++dd) S[dd] = sj[2048 + pq * 8 + dd] * S[dd] + sj[(pq * 8 + dd) * 64 + e];
        }
      } else {
        for (int j = cfirst + nc - 1; j > cgi; --j) {
          const float* sj = GS + (size_t)((j * 4 + h) * 2 + 1) * 2080;
#pragma unroll
          for (int dd = 0; dd < 8; ++dd) S[dd] = sj[2048 + pq * 8 + dd] * S[dd] + sj[(pq * 8 + dd) * 64 + e];
        }
      }
#pragma unroll
      for (int dd = 0; dd < 8; ++dd) Sp[(pq * 8 + dd) * 64 + e] = S[dd];
      const bool last = dir == 0 ? (cgi == cfirst + nc - 1) : (cgi == cfirst);
      if (ci == 0 && last) {
        const float* sj = GS + (size_t)((cgi * 4 + h) * 2 + dir) * 2080;
        const int b = start >> 8;
        float* dst = P.out + OUT_SG + ((((size_t)b * 2 + l) * 2 + dir) * 4 + h) * 2048;
#pragma unroll
        for (int dd = 0; dd < 8; ++dd) dst[(pq * 8 + dd) * 64 + e] = sj[2048 + pq * 8 + dd] * S[dd] + sj[(pq * 8 + dd) * 64 + e];
      }
    }
    {
      const int pp = tid >> 2, q4 = tid & 3, tok = dir ? c0 + 63 - pp : c0 + pp;
      const uint4 qv = *(const uint4*)(U + (size_t)tok * NU + UGQ + h * 32 + q4 * 8);
      const uint4 kv = *(const uint4*)(U + (size_t)tok * NU + UGK + h * 32 + q4 * 8);
      const unsigned qw[4] = {qv.x, qv.y, qv.z, qv.w};
      const unsigned kw[4] = {kv.x, kv.y, kv.z, kv.w};
#pragma unroll
      for (int i = 0; i < 4; ++i) {
        const int d = q4 * 8 + 2 * i;
        const float b0 = gs[pp * 32 + d], b1 = gs[pp * 32 + d + 1];
        qt[pp * 32 + d] = bflo(qw[i]) * 0.17677669529663687f * __expf(b0);
        qt[pp * 32 + d + 1] = bfhi(qw[i]) * 0.17677669529663687f * __expf(b1);
        kt[pp * 32 + d] = bflo(kw[i]) * __expf(-b0);
        kt[pp * 32 + d + 1] = bfhi(kw[i]) * __expf(-b1);
      }
      const uint4* vp = (const uint4*)(U + (size_t)tok * NU + UGV + h * 64 + q4 * 16);
      const uint4 v0 = vp[0], v1 = vp[1];
      const unsigned vw[8] = {v0.x, v0.y, v0.z, v0.w, v1.x, v1.y, v1.z, v1.w};
#pragma unroll
      for (int i = 0; i < 8; ++i) { vs[pp * 64 + q4 * 16 + 2 * i] = bflo(vw[i]); vs[pp * 64 + q4 * 16 + 2 * i + 1] = bfhi(vw[i]); }
    }
    __syncthreads();
    {
      const int pp = tid >> 2, sq = tid & 3;
      float qr[32];
#pragma unroll
      for (int d = 0; d < 32; ++d) qr[d] = qt[pp * 32 + d];
#pragma unroll 1
      for (int si = 0; si < 16; ++si) {
        const int s = sq * 16 + si;
        float a = 0.f;
        if (s <= pp) {
#pragma unroll
          for (int d = 0; d < 32; ++d) a += qr[d] * kt[s * 32 + d];
        }
        att[pp * 65 + s] = a;
      }
    }
    __syncthreads();
    {
#pragma unroll 2
      for (int s = 0; s < 64; ++s) {
        const float vv = vs[s * 64 + e];
#pragma unroll
        for (int i = 0; i < 16; ++i) { const int tau = pq * 16 + i, pp = dir ? 63 - tau : tau; oacc[i] += att[pp * 65 + s] * vv; }
      }
#pragma unroll 2
      for (int d = 0; d < 32; ++d) {
        const float sv = Sp[d * 64 + e];
#pragma unroll
        for (int i = 0; i < 16; ++i) { const int tau = pq * 16 + i, pp = dir ? 63 - tau : tau; oacc[i] += qt[pp * 32 + d] * sv; }
      }
    }
    __syncthreads();
  }
  float* OG = (float*)(PWS + OFF_M + M_OG);
#pragma unroll
  for (int i = 0; i < 16; ++i) OG[(size_t)(c0 + pq * 16 + i) * 256 + h * 64 + e] = oacc[i];
}

#define SC_BUF 22528
__device__ __forceinline__ void rwkv_scan(const Params& P, int l, int item, bool dry, unsigned char* smem) {
  const int tid = otid();
  int seq, sub;
  if (item < 64) { seq = 16 + (item >> 5); sub = item & 31; } else { seq = (item - 64) >> 5; sub = (item - 64) & 31; }
  const int h = sub >> 3, dir = (sub >> 2) & 1, rg = sub & 3;
  const int start = seq < 16 ? seq * 256 : 4096 + (seq - 16) * 4096, L = seq < 16 ? 256 : 4096;
  const int rowl = tid >> 4, j = tid & 15, row = rg * 16 + rowl;
  unsigned char* ws = PWS;
  const float* Wd = (const float*)(ws + OFF_M + M_W) + (size_t)dir * NT * 256 + h * 64 + j * 4;
  const bf16_t* KD = (const bf16_t*)(ws + OFF_M + M_KD) + (size_t)dir * NT * 256 + h * 64 + j * 4;
  const bf16_t* Bb = (const bf16_t*)(ws + OFF_M + M_B) + (size_t)dir * NT * 256 + h * 64 + j * 4;
  const bf16_t* Rr = (const bf16_t*)(ws + OFF_M + M_R) + h * 64 + j * 4;
  const bf16_t* KKn = (const bf16_t*)(ws + OFF_M + M_KK) + h * 64 + j * 4;
  const bf16_t* Vv = (const bf16_t*)(ws + OFF_M + M_V) + h * 64 + rg * 16 + j;
  float* ORW = (float*)(ws + OFF_ORW) + h * 64 + rg * 16 + j;
  typedef float f32x2 __attribute__((ext_vector_type(2)));
  f32x2 S01, S23;
  if (seq < 16) {
    S01 = (f32x2){0.f, 0.f}; S23 = (f32x2){0.f, 0.f};
  } else {
    const f32x4 s0 = *(const f32x4*)(P.in[I_SRW] + (((((size_t)(seq - 16) * 2 + l) * 2 + dir) * 4 + h) * 64 + row) * 64 + j * 4);
    S01 = (f32x2){s0[0], s0[1]}; S23 = (f32x2){s0[2], s0[3]};
  }
  f32x4 gw; uint2 gkd, gb, gkk, gr; unsigned gv;
  const int nch = L >> 4;
#define SC_TOK(c_) ((size_t)(start + (dir ? L - 1 - ((c_) * 16 + rowl) : (c_) * 16 + rowl)))
#define SC_LOAD(c_) { const size_t tk = SC_TOK(c_) * 256; gw = *(const f32x4*)(Wd + tk); gkd = *(const uint2*)(KD + tk); gb = *(const uint2*)(Bb + tk); \
    gkk = *(const uint2*)(KKn + tk); gr = *(const uint2*)(Rr + tk); gv = Vv[tk]; }
#define SC_STORE(b_) { float* base = (float*)(smem + (b_) * SC_BUF) + rowl * 64 + j * 4; \
    *(f32x4*)(base) = gw; \
    *(f32x4*)(base + 1024) = (f32x4){bflo(gkd.x), bfhi(gkd.x), bflo(gkd.y), bfhi(gkd.y)}; \
    *(f32x4*)(base + 2048) = (f32x4){bflo(gb.x), bfhi(gb.x), bflo(gb.y), bfhi(gb.y)}; \
    *(f32x4*)(base + 3072) = (f32x4){bflo(gkk.x), bfhi(gkk.x), bflo(gkk.y), bfhi(gkk.y)}; \
    *(f32x4*)(base + 4096) = (f32x4){bflo(gr.x), bfhi(gr.x), bflo(gr.y), bfhi(gr.y)}; \
    ((float*)(smem + (b_) * SC_BUF + 20480))[j * 16 + rowl] = __uint_as_float(gv << 16); }
  SC_LOAD(0)
  SC_STORE(0)
  if (nch > 1) SC_LOAD(1)
  __syncthreads();
#pragma unroll 1
  for (int c = 0; c < nch; ++c) {
    const float* buf = (const float*)(smem + (c & 1) * SC_BUF);
    float* outl = (float*)(smem + (c & 1) * SC_BUF + 21504);
    float myout = 0.f;
    f32x4 v4[4];
#pragma unroll
    for (int i = 0; i < 4; ++i) v4[i] = *(const f32x4*)(buf + 5120 + rowl * 16 + i * 4);
    f32x4 w4 = *(const f32x4*)(buf + j * 4), kd4 = *(const f32x4*)(buf + 1024 + j * 4), b4 = *(const f32x4*)(buf + 2048 + j * 4),
          kk4 = *(const f32x4*)(buf + 3072 + j * 4), r4 = *(const f32x4*)(buf + 4096 + j * 4);
    float dot;
    {
      f32x2 p = S01 * (f32x2){kk4[0], kk4[1]};
      p = S23 * (f32x2){kk4[2], kk4[3]} + p;
      dot = row16_sum(p[0] + p[1]);
    }
#pragma unroll
    for (int s = 0; s < 16; ++s) {
      f32x4 w4n, kd4n, b4n, kk4n, r4n;
      if (s < 15) {
        w4n = *(const f32x4*)(buf + (s + 1) * 64 + j * 4);
        kd4n = *(const f32x4*)(buf + 1024 + (s + 1) * 64 + j * 4);
        b4n = *(const f32x4*)(buf + 2048 + (s + 1) * 64 + j * 4);
        kk4n = *(const f32x4*)(buf + 3072 + (s + 1) * 64 + j * 4);
        r4n = *(const f32x4*)(buf + 4096 + (s + 1) * 64 + j * 4);
      }
      __builtin_amdgcn_sched_barrier(0);
      const float vf = v4[s >> 2][s & 3];
      const f32x2 t01 = S01 * (f32x2){w4[0], w4[1]} + (f32x2){kd4[0], kd4[1]} * vf;
      const f32x2 t23 = S23 * (f32x2){w4[2], w4[3]} + (f32x2){kd4[2], kd4[3]} * vf;
      S01 = t01 - (f32x2){b4[0], b4[1]} * dot;
      S23 = t23 - (f32x2){b4[2], b4[3]} * dot;
      f32x2 o = S01 * (f32x2){r4[0], r4[1]};
      o = S23 * (f32x2){r4[2], r4[3]} + o;
      float od = o[0] + o[1];
      if (s < 15) {
        f32x2 p = S01 * (f32x2){kk4n[0], kk4n[1]};
        p = S23 * (f32x2){kk4n[2], kk4n[3]} + p;
        float dn = p[0] + p[1];
        row16_sum2(dn, od);
        dot = dn;
        w4 = w4n; kd4 = kd4n; b4 = b4n; kk4 = kk4n; r4 = r4n;
      } else {
        od = row16_sum(od);
      }
      myout = (j == s) ? od : myout;
    }
    outl[j * 16 + rowl] = myout;
    if (c + 1 < nch) SC_STORE((c + 1) & 1)
    __syncthreads();
    if (!dry) __hip_atomic_fetch_add(ORW + SC_TOK(c) * 256, outl[rowl * 16 + j], __ATOMIC_RELAXED, __HIP_MEMORY_SCOPE_AGENT);
    if (c + 2 < nch) SC_LOAD(c + 2)
  }
#undef SC_TOK
#undef SC_LOAD
#undef SC_STORE
  if (seq < 16 && !dry) {
    f32x4 o; o[0] = S01[0]; o[1] = S01[1]; o[2] = S23[0]; o[3] = S23[1];
    *(f32x4*)(P.out + OUT_SR + (((((size_t)seq * 2 + l) * 2 + dir) * 4 + h) * 64 + row) * 64 + j * 4) = o;
  }
  __syncthreads();
}

__device__ __forceinline__ void fourier_tile(const Params& P, int item, unsigned char* smem) {
  int seq, mt, nt;
  if (item < 128) { seq = 16 + (item >> 6); mt = (item >> 1) & 31; nt = item & 1; }
  else { const int r = item - 128; seq = r >> 2; mt = (r >> 1) & 1; nt = r & 1; }
  const int start = seq < 16 ? seq * 256 : 4096 + (seq - 16) * 4096, L = seq < 16 ? 256 : 4096, sh = seq < 16 ? 4 : 0;
  const bf16_t* ZT = (const bf16_t*)(PWS + OFF_ZT);
  bf16_t* YS = (bf16_t*)(PWS + OFF_YS);
  f32x4 acc[4][4]; ACC_ZERO(acc);
  if (seq < 16) {
    gemm_acc<1, 4, 4>(acc, nullptr, 0, ZT + (size_t)(nt * 128) * NT + start, NT, smem, mt * 128, 255, 4, 0, 0);
    gemm_acc<1, 4, 4>(acc, nullptr, 0, ZT + (size_t)(256 + nt * 128) * NT + start, NT, smem, mt * 128, 255, 4, 3072, 0);
  } else {
#pragma unroll 1
    for (int pass = 0; pass < 8; ++pass) {
      const int nb = (pass & 3) * 1024, sn = pass >> 2;
      gemm_acc<1, 4, 16>(acc, nullptr, 0, ZT + (size_t)(sn * 256 + nt * 128) * NT + start + nb, NT, smem, mt * 128, 4095, 0, sn ? 3072 : 0, nb);
    }
  }
  const float scl = seq < 16 ? 0.0625f : 0.015625f;
  EPI_BEGIN(acc)
    uint4 pk; pk.x = pk2(v0[0] * scl, v0[1] * scl); pk.y = pk2(v0[2] * scl, v0[3] * scl); pk.z = pk2(v1[0] * scl, v1[1] * scl); pk.w = pk2(v1[2] * scl, v1[3] * scl);
    *(uint4*)(YS + (size_t)(start + mt * 128 + r) * 1024 + 256 + nt * 128 + c) = pk;
  EPI_END
}

#define CT 24
__device__ __forceinline__ void combine_tile(const Params& P, int l, int tile, unsigned char* smem) {
  const int tid = otid(), tok0 = tile * CT, col = tid;
  const bf16_t* U = (const bf16_t*)(PWS + OFF_U);
  bf16_t* YS = (bf16_t*)(PWS + OFF_YS);
  float* sg = (float*)smem;
  for (int i = tid; i < CT * 64; i += 256) sg[i] = sigmoidf_(bf2f(U[(size_t)(tok0 + (i >> 6)) * NU + UCG + (i & 63)]));
  __syncthreads();
  float gate[CT];
  {
    float wreg[64];
    const float* bg = P.in[I_BG] + (size_t)l * 64 * 256 + col;
#pragma unroll
    for (int r = 0; r < 64; ++r) wreg[r] = bg[r * 256];
#pragma unroll
    for (int tt = 0; tt < CT; ++tt) {
      float a0 = 0.f, a1 = 0.f;
#pragma unroll
      for (int r4 = 0; r4 < 16; ++r4) {
        const f32x4 x4 = *(const f32x4*)(sg + tt * 64 + r4 * 4);
        a0 += x4[0] * wreg[r4 * 4] + x4[2] * wreg[r4 * 4 + 2];
        a1 += x4[1] * wreg[r4 * 4 + 1] + x4[3] * wreg[r4 * 4 + 3];
      }
      gate[tt] = a0 + a1;
    }
  }
  const bf16_t* Rr = (const bf16_t*)(PWS + OFF_M + M_R);
  const bf16_t* Vv = (const bf16_t*)(PWS + OFF_M + M_V);
  const bf16_t* KD = (const bf16_t*)(PWS + OFF_M + M_KD);
  const float* ORW = (const float*)(PWS + OFF_ORW);
  const float* OG = (const float*)(PWS + OFF_M + M_OG);
  const float gn = P.in[I_GN][l * 256 + col], rk = P.in[I_RK][l * 256 + col], gnorm = P.in[I_GNORM][l * 256 + col];
#pragma unroll
  for (int tt = 0; tt < CT; ++tt) {
    const size_t o = (size_t)(tok0 + tt) * 256 + col;
    const float ov = ORW[o];
    const float mu = wave_sum(ov) * (1.f / 64.f);
    const float dv = ov - mu;
    const float var = wave_sum(dv * dv) * (1.f / 64.f);
    const float on = dv * rsqrtf(var + 64e-5f) * gn;
    const float r = bf2f(Rr[o]), v = bf2f(Vv[o]);
    const float kds = bf2f(KD[o]) + bf2f(KD[(size_t)NT * 256 + o]);
    const float bonus = wave_sum(r * kds * rk);
    const float yc = (on + bonus * v) * gate[tt];
    YS[(size_t)(tok0 + tt) * 1024 + 512 + col] = f2bf(yc);
    const float og = OG[o];
    const float ms = wave_sum(og * og) * (1.f / 64.f);
    const float go = bf2f(U[(size_t)(tok0 + tt) * NU + UGO + col]);
    const float yd = og * rsqrtf(ms + 1e-6f) * gnorm * (go * sigmoidf_(go));
    YS[(size_t)(tok0 + tt) * 1024 + 768 + col] = f2bf(yd);
  }
  __syncthreads();
}


#define OFF_BAR WS_END
#define XB_TMO      128
#define XB_XCNT(j)  (256  + 64 * (j))
#define XB_XSUB(j)  (1280 + 64 * (j))
#define XB_XGEN(j)  (2304 + 64 * (j))
#define XB_TOP      3328
#define XB_TOPGEN   3392
#define XCD_BAR_WORDS 3456
#define XB_SPIN_CAP (1u << 18)
#define LAS __attribute__((address_space(3)))

__device__ __forceinline__ unsigned xb_ld(unsigned* p)              { return __hip_atomic_load(p, __ATOMIC_RELAXED, __HIP_MEMORY_SCOPE_AGENT); }
__device__ __forceinline__ unsigned xb_add(unsigned* p, unsigned v) { return __hip_atomic_fetch_add(p, v, __ATOMIC_RELAXED, __HIP_MEMORY_SCOPE_AGENT); }
__device__ __forceinline__ unsigned xb_xcc_id() { return (unsigned)__builtin_amdgcn_s_getreg((3 << 11) | 20) & 0xFu; }
#define XB_SPIN(cond, bar) do { unsigned _sp = 0; while (cond) { __builtin_amdgcn_s_sleep(1); \
    if ((++_sp & 255u) == 0u) { if (xb_ld(&(bar)[XB_TMO])) break; if (_sp > XB_SPIN_CAP) { atomicAdd(&(bar)[XB_TMO], 1u); break; } } } } while (0)

struct XcdBarrier {
    unsigned* bar; unsigned x;
    volatile LAS unsigned* st;
};

__device__ __forceinline__ XcdBarrier xcd_barrier_post(unsigned* bar, volatile LAS unsigned* st) {
    XcdBarrier b; b.bar = bar; b.x = xb_xcc_id(); b.st = st;
    if (otid() == 0) st[2] = xb_add(&bar[XB_XCNT(b.x)], 1u);
    return b;
}
__device__ __forceinline__ void xcd_barrier_complete(unsigned* bar, unsigned x, unsigned& nloc, unsigned& nx) {
    const unsigned G = gridDim.x * gridDim.y * gridDim.z;
    unsigned sum, cnt, mine, sp = 0u;
    for (;;) {
        sum = 0u; cnt = 0u; mine = 0u;
#pragma unroll
        for (unsigned j = 0; j < 16; ++j) { const unsigned c = xb_ld(&bar[XB_XCNT(j)]); sum += c; cnt += (c > 0u) ? 1u : 0u; mine = (j == x) ? c : mine; }
        if (sum == G) break;
        __builtin_amdgcn_s_sleep(1);
        if ((++sp & 255u) == 0u) { if (xb_ld(&bar[XB_TMO])) break; if (sp > XB_SPIN_CAP) { atomicAdd(&bar[XB_TMO], 1u); break; } }
    }
    nloc = mine > 0u ? mine : 1u; nx = cnt > 0u ? cnt : 1u;
}

__device__ __forceinline__ void xcd_barrier(const XcdBarrier& b) {
    asm volatile("s_waitcnt vmcnt(0)" ::: "memory");
    __syncthreads();
    if (otid() == 0) {
        unsigned* bar = b.bar;
        __builtin_amdgcn_s_waitcnt(0);
        unsigned nloc = b.st[0], nx = b.st[1];
        if (nloc == 0u) { xcd_barrier_complete(bar, b.x, nloc, nx); b.st[0] = nloc; b.st[1] = nx; }
        const unsigned old = xb_add(&bar[XB_XSUB(b.x)], 1u);
        const unsigned gen = old / nloc;
        if (old + 1u == (gen + 1u) * nloc) {
            __builtin_amdgcn_fence(__ATOMIC_RELEASE, "agent");
            asm volatile("s_waitcnt vmcnt(0)" ::: "memory");
            const unsigned og = xb_add(&bar[XB_TOP], 1u);
            const unsigned tg = og / nx;
            if (og + 1u == (tg + 1u) * nx) xb_add(&bar[XB_TOPGEN], 1u);
            else XB_SPIN(xb_ld(&bar[XB_TOPGEN]) == tg, bar);
            __builtin_amdgcn_fence(__ATOMIC_ACQUIRE, "agent");
            xb_add(&bar[XB_XGEN(b.x)], 1u);
            asm volatile("s_waitcnt vmcnt(0)" ::: "memory");
        } else {
            XB_SPIN(xb_ld(&bar[XB_XGEN(b.x)]) == gen, bar);
            __builtin_amdgcn_fence(__ATOMIC_ACQUIRE, "agent");
            asm volatile("s_waitcnt vmcnt(0)" ::: "memory");
        }
    }
    __syncthreads();
}
#define gsync(P_, e_) xcd_barrier(xb)

#ifndef R_P0
#define R_P0 1
#endif
#ifndef R_NORM
#define R_NORM 1
#endif
#ifndef R_GEMM
#define R_GEMM 1
#endif
#ifndef R_PREP
#define R_PREP 1
#endif
#ifndef R_SCAN
#define R_SCAN 1
#endif
#ifndef R_FOUR
#define R_FOUR 1
#endif
#ifndef R_G2
#define R_G2 1
#endif
#define REP(n) for (int rep = 0; rep < 1; ++rep)
__global__ void __launch_bounds__(256, 2) mega(Params P) {
  extern __shared__ __attribute__((aligned(16))) unsigned char smem[];
  cg::grid_group grid = cg::this_grid();
  const int G = gridDim.x;
  unsigned epoch = 0;
  int zero = 0; asm volatile("" : "+s"(zero));
  volatile LAS unsigned* xst = (volatile LAS unsigned*)(LAS unsigned char*)(smem + LDS_BYTES - 16);
  if (otid() == 0) { xst[0] = 0u; xst[1] = 0u; }
  __syncthreads();
  XcdBarrier xb = xcd_barrier_post((unsigned*)(PWS + OFF_BAR), xst);
  grid.sync();
  REP(R_P0) {
    phase_mod(P, smem);
    __syncthreads();
    phase_table(P);
    {
      const int nb = G > 256 ? G - 192 : G;
      if (G > 256) { if ((int)blockIdx.x >= 192) phase_convert(P, 0, smem, blockIdx.x - 192, nb); }
      else phase_convert(P, 0, smem, blockIdx.x, nb);
    }
  }
  gsync(P, epoch);
  TL tl;
  {
    const unsigned nloc = xst[0], nx = xst[1], jl = xst[2];
    if (nx == 8u && xb.x < 8u && nloc > 0u) { tl.x = (int)xb.x; tl.j = (int)jl; tl.n = (int)nloc; }
    else { tl.x = blockIdx.x & 7; tl.j = blockIdx.x >> 3; tl.n = G >> 3; }
  }
#pragma unroll 1
  for (int l = 0; l < 2; ++l) {
    REP(R_NORM) {
      if (l == 1) phase_convert(P, 1, smem, blockIdx.x, G);
      phase_norm(P, l, 0);
    }
    gsync(P, epoch);
    REP(R_GEMM) phase_gemm1(P, smem, tl);
#ifdef DUP_GEMM
    phase_gemm1(P, smem, tl);
#endif
    gsync(P, epoch);
    if (G > 384 + 64) {
      if ((int)blockIdx.x < 384) prep_tile(P, l, blockIdx.x, smem);
      else for (int it = blockIdx.x - 384; it < 1536; it += G - 384) gla_g1(P, l, it, smem);
    } else {
      for (int it = blockIdx.x; it < 384 + 1536; it += G) {
        if (it < 384) prep_tile(P, l, it, smem); else gla_g1(P, l, it - 384, smem);
      }
    }
#ifdef DUP_PREP
    for (int it = blockIdx.x; it < 384; it += G) prep_tile(P, l, it, smem);
#endif
#ifdef DUP_G1
    for (int it = blockIdx.x + 384; it < 384 + 1536; it += G) gla_g1(P, l, it - 384, smem);
#endif
    gsync(P, epoch);
    {
      const bf16_t* tabg = (const bf16_t*)(PWS + OFF_TAB);
      bf16_t* tabl = (bf16_t*)(smem + LDS_TAB);
      for (int i = otid(); i < 4096; i += 256) tabl[i] = tabg[i];
      __syncthreads();
      if (G >= 256) {
        const int b = blockIdx.x;
        const bool is_scan = b < 128 && (b & 8) == 0;
        if (is_scan) rwkv_scan(P, l, (b >> 4) * 8 + (b & 7), false, smem);
        else {
          const int ob = b < 128 ? (b >> 4) * 8 + (b & 7) : b - 64;
          for (int it = 64 + ob; it < 576 + 192 + 768 + 384; it += G - 64) {
            if (it < 576) rwkv_scan(P, l, it, false, smem);
            else if (it < 768) fourier_tile(P, it - 576, smem);
            else if (it < 1536) gla_g2(P, l, it - 768, smem);
            else pool_tile(P, l, it - 1536, smem);
          }
        }
      } else {
        for (int it = blockIdx.x; it < 576 + 192 + 768 + 384; it += G) {
          if (it < 576) rwkv_scan(P, l, it, false, smem);
          else if (it < 768) fourier_tile(P, it - 576, smem);
          else if (it < 1536) gla_g2(P, l, it - 768, smem);
          else pool_tile(P, l, it - 1536, smem);
        }
      }
    }
    gsync(P, epoch);
    REP(R_PREP) for (int it = blockIdx.x; it < NT / CT; it += G) combine_tile(P, l, it, smem);
#ifdef DUP_COMB
    for (int it = blockIdx.x; it < 384; it += G) combine_tile(P, l, it, smem);
#endif
    gsync(P, epoch);
    REP(R_GEMM) phase_gemm_mlog(P, smem, tl);
#ifdef DUP_GEMM
    phase_gemm_mlog(P, smem, tl);
#endif
    gsync(P, epoch);
    REP(R_GEMM) phase_merge(P, smem, tl);
#ifdef DUP_GEMM
    phase_merge(P, smem, tl);
#endif
    gsync(P, epoch);
    REP(R_GEMM) phase_gemm_res(P, l, 0, smem, rep > 0, tl);
    gsync(P, epoch);
    REP(R_NORM) phase_norm(P, l, 1);
    gsync(P, epoch);
    REP(R_GEMM) phase_mlp_up(P, smem, tl);
#ifdef DUP_GEMM
    phase_mlp_up(P, smem, tl);
#endif
    gsync(P, epoch);
    REP(R_GEMM) phase_gemm_res(P, l, 1, smem, rep > 0, tl);
    gsync(P, epoch);
  }
#ifdef R_SYNC
  for (int i = 0; i < R_SYNC + zero; ++i) gsync(P, epoch);
#endif
  phase_norm(P, 0, 2);
}

extern "C" void kernel_launch(void* const* d_in, const int* in_sizes, int n_in, void* d_out, int out_size, void* d_ws, size_t ws_size,
                              hipStream_t stream) {
  static int grid_blocks = 0;
  if (!grid_blocks) {
    int dev = 0, cus = 0, per_cu = 0;
    hipGetDevice(&dev);
    hipDeviceGetAttribute(&cus, hipDeviceAttributeMultiprocessorCount, dev);
    hipFuncSetAttribute((const void*)mega, hipFuncAttributeMaxDynamicSharedMemorySize, LDS_BYTES);
    hipOccupancyMaxActiveBlocksPerMultiprocessor(&per_cu, (const void*)mega, 256, LDS_BYTES);
    per_cu = 2;
    grid_blocks = cus * per_cu;
    if (ws_size < WS_END) fprintf(stderr, "kernel_launch: workspace too small: %zu < %llu\n", ws_size, (unsigned long long)WS_END);
  }
  Params p{};
  for (int i = 0; i < 31; ++i) p.in[i] = (const float*)d_in[i];
  p.out = (float*)d_out;
  p.ws_ = (unsigned char*)d_ws;
  hipMemsetAsync((unsigned char*)d_ws + OFF_BAR, 0, XCD_BAR_WORDS * 4, stream);
  void* args[] = {&p};
  hipError_t e = hipLaunchCooperativeKernel((const void*)mega, dim3(grid_blocks), dim3(256), args, LDS_BYTES, stream);
  if (e != hipSuccess) fprintf(stderr, "cooperative launch failed: %s (grid %d)\n", hipGetErrorString(e), grid_blocks);
}
```

```cpp
#define TILE_STRIP 6
#include <hip/hip_runtime.h>
#include <hip/hip_cooperative_groups.h>
#include <cstdio>
#include <cstdint>
namespace cg = cooperative_groups;

typedef unsigned short bf16_t;
typedef short bf16x8 __attribute__((ext_vector_type(8)));
typedef float f32x4 __attribute__((ext_vector_type(4)));

#define NT 12288
#define DM 1024
#define NU 2176
#define NWIN 6784
#define DFF 4096
#define UP 0
#define UR 256
#define UK 512
#define UV 768
#define UCW 1024
#define UCA 1152
#define UCG 1216
#define UGQ 1280
#define UGK 1408
#define UGV 1536
#define UGO 1792
#define UCAL 2048

#define OFF_MOD 0ull
#define OFF_TAB 147456ull
#define OFF_WIN 155648ull
#define OFF_WB 14049280ull
#define OFF_WO 16146432ull
#define OFF_W1 18243584ull
#define OFF_W2 26632192ull
#define OFF_H 35020800ull
#define OFF_U 60186624ull
#define OFF_ZT 113664000ull
#define OFF_YS 126246912ull
#define OFF_ORW 151412736ull
#define OFF_M 163995648ull
#define WS_END 264658944ull
#define M_R 0ull
#define M_V 6291456ull
#define M_KK 12582912ull
#define M_KD 18874368ull
#define M_B 31457280ull
#define M_W 44040192ull
#define M_OG 69206016ull
#define M_GS 81788928ull

#define OUT_SR 12582912ull
#define OUT_SG 13631488ull

#define LDS_BYTES 74256
#define LDS_TAB 66048

struct Params {
  const float* in[31];
  float* out;
  unsigned char* ws_;
};
enum { I_XP = 0, I_XS, I_SRW, I_SGL, I_C, I_CCTX, I_ADAW, I_ADAB, I_N1G, I_N2G, I_WIN, I_POOLW, I_POOLS, I_MU, I_W0, I_BW,
       I_A0, I_BA, I_KKP, I_KA, I_BG, I_RK, I_GN, I_GAB, I_GABIAS, I_GNORM, I_WBR, I_WOUT, I_W1, I_W2, I_FG };

__device__ __forceinline__ bf16_t f2bf(float f) {
  unsigned u = __float_as_uint(f);
  u += 0x7fffu + ((u >> 16) & 1u);
  return (bf16_t)(u >> 16);
}
__device__ __forceinline__ float bf2f(bf16_t h) { return __uint_as_float(((unsigned)h) << 16); }
__device__ __forceinline__ unsigned pk2(float a, float b) { return (unsigned)f2bf(a) | ((unsigned)f2bf(b) << 16); }
__device__ __forceinline__ float bflo(unsigned u) { return __uint_as_float(u << 16); }
__device__ __forceinline__ float bfhi(unsigned u) { return __uint_as_float(u & 0xffff0000u); }
__device__ __forceinline__ float sigmoidf_(float x) { return __frcp_rn(1.f + __expf(-x)); }
__device__ __forceinline__ float row16_sum(float v);
__device__ __forceinline__ float wave_sum(float v) {
  v = row16_sum(v);
  const int iv = __builtin_bit_cast(int, v);
  const float s0 = __builtin_bit_cast(float, __builtin_amdgcn_readlane(iv, 0)), s1 = __builtin_bit_cast(float, __builtin_amdgcn_readlane(iv, 16));
  const float s2 = __builtin_bit_cast(float, __builtin_amdgcn_readlane(iv, 32)), s3 = __builtin_bit_cast(float, __builtin_amdgcn_readlane(iv, 48));
  return (s0 + s1) + (s2 + s3);
}
__device__ __forceinline__ float row16_sum(float v) {
  v += __builtin_bit_cast(float, __builtin_amdgcn_update_dpp(0, __builtin_bit_cast(int, v), 0x128, 0xf, 0xf, false));
  v += __builtin_bit_cast(float, __builtin_amdgcn_update_dpp(0, __builtin_bit_cast(int, v), 0x124, 0xf, 0xf, false));
  v += __builtin_bit_cast(float, __builtin_amdgcn_update_dpp(0, __builtin_bit_cast(int, v), 0x122, 0xf, 0xf, false));
  v += __builtin_bit_cast(float, __builtin_amdgcn_update_dpp(0, __builtin_bit_cast(int, v), 0x121, 0xf, 0xf, false));
  return v;
}
#define DPP_ADD(v_, ctrl_) v_ += __builtin_bit_cast(float, __builtin_amdgcn_update_dpp(0, __builtin_bit_cast(int, v_), ctrl_, 0xf, 0xf, false))
__device__ __forceinline__ void row16_sum2(float& a, float& b) {
  DPP_ADD(a, 0x128); DPP_ADD(b, 0x128); DPP_ADD(a, 0x124); DPP_ADD(b, 0x124); DPP_ADD(a, 0x122); DPP_ADD(b, 0x122); DPP_ADD(a, 0x121); DPP_ADD(b, 0x121);
}
__device__ __forceinline__ void seq_of_tok(int tok, int& start, int& L, int& ci) {
  if (tok < 4096) { start = tok & ~255; L = 256; ci = 0; }
  else { int b = (tok - 4096) >> 12; start = 4096 + (b << 12); L = 4096; ci = 1 + b; }
}

__device__ __forceinline__ size_t oz0() { size_t z = 0; asm volatile("" : "+s"(z)); return z; }
#define PWS (P.ws_ + oz0())
__device__ __forceinline__ int otid() { int t = threadIdx.x; asm volatile("" : "+v"(t)); return t; }
template <int AMODE, int NF, int NK>
__device__ __forceinline__ void gemm_acc(f32x4 (&acc)[4][NF], const bf16_t* __restrict__ A, int lda, const bf16_t* __restrict__ B, int ldb,
                                         unsigned char* smem, int k1base = 0, int Lmask = 0, int sh = 0, int ph = 0, int nbase = 0) {
  const int tid = otid(), lane = tid & 63, wid = tid >> 6, wr = wid >> 1, wc = wid & 1;
  bf16_t* sA = (bf16_t*)smem;
  bf16_t* sB = (bf16_t*)(smem + 32768);
  const bf16_t* tab = (const bf16_t*)(smem + LDS_TAB);
  uint4 ra0x, ra1x, ra2x, ra3x, rb0x, rb1x, rb2x, rb3x, ra0y, ra1y, ra2y, ra3y, rb0y, rb1y, rb2y, rb3y;
  const int row0 = tid >> 3, kc0 = tid & 7;
  const int soff = row0 * 64 + ((kc0 ^ ((row0 >> 1) & 7)) << 3);
  const int rho0 = (((row0 >> 2) & 1) << 4) | ((row0 >> 3) << 2) | (row0 & 3);
  const int soffB = rho0 * 64 + ((kc0 ^ ((rho0 >> 1) & 7)) << 3);
  const bf16_t* Ap = A + (size_t)row0 * lda + kc0 * 8;
  const bf16_t* Bp = B + (size_t)row0 * ldb + kc0 * 8;
#define GL1(r_, P_, ld_, i_, kt_) r_ = *(const uint4*)(P_ + (size_t)(32 * i_) * ld_ + (kt_) * 64);
#define GLOAD(X, kt) { if (AMODE == 0) { GL1(ra0##X, Ap, lda, 0, kt) GL1(ra1##X, Ap, lda, 1, kt) GL1(ra2##X, Ap, lda, 2, kt) GL1(ra3##X, Ap, lda, 3, kt) } \
    GL1(rb0##X, Bp, ldb, 0, kt) GL1(rb1##X, Bp, ldb, 1, kt) if (NF == 4) { GL1(rb2##X, Bp, ldb, 2, kt) GL1(rb3##X, Bp, ldb, 3, kt) } }
#define TABV(dst_) { const unsigned lo = tab[((idx << sh) + ph) & 4095]; idx = (idx + k1) & Lmask; const unsigned hi = tab[((idx << sh) + ph) & 4095]; idx = (idx + k1) & Lmask; dst_ = lo | (hi << 16); }
#define GEN1(r_, i_, kt_) { const int k1 = k1base + row0 + 32 * i_, n = nbase + (kt_) * 64 + kc0 * 8; int idx = (k1 * n) & Lmask; TABV(r_.x) TABV(r_.y) TABV(r_.z) TABV(r_.w) }
#define SSTORE(X, buf, kt) { if (AMODE == 1) { GEN1(ra0##X, 0, kt) GEN1(ra1##X, 1, kt) GEN1(ra2##X, 2, kt) GEN1(ra3##X, 3, kt) } \
    *(uint4*)(sA + (buf) * 8192 + soff) = ra0##X; *(uint4*)(sA + (buf) * 8192 + soff + 2048) = ra1##X; *(uint4*)(sA + (buf) * 8192 + soff + 4096) = ra2##X; *(uint4*)(sA + (buf) * 8192 + soff + 6144) = ra3##X; \
    *(uint4*)(sB + (buf) * 8192 + soffB) = rb0##X; *(uint4*)(sB + (buf) * 8192 + soffB + 2048) = rb1##X; \
    if (NF == 4) { *(uint4*)(sB + (buf) * 8192 + soffB + 4096) = rb2##X; *(uint4*)(sB + (buf) * 8192 + soffB + 6144) = rb3##X; } }
#define COMPUTE(buf) { \
    _Pragma("unroll") for (int ks = 0; ks < 2; ++ks) { \
      bf16x8 af[4], bfr[NF]; \
      const int q = ks * 4 + (lane >> 4); \
      _Pragma("unroll") for (int m = 0; m < 4; ++m) { const int r = wr * 64 + m * 16 + (lane & 15); af[m] = *(const bf16x8*)(sA + (buf) * 8192 + r * 64 + ((q ^ ((r >> 1) & 7)) << 3)); } \
      _Pragma("unroll") for (int n = 0; n < NF; ++n) { const int r = wc * (NF * 16) + n * 16 + (lane & 15); bfr[n] = *(const bf16x8*)(sB + (buf) * 8192 + r * 64 + ((q ^ ((r >> 1) & 7)) << 3)); } \
      _Pragma("unroll") for (int m = 0; m < 4; ++m) \
        _Pragma("unroll") for (int n = 0; n < NF; ++n) acc[m][n] = __builtin_amdgcn_mfma_f32_16x16x32_bf16(bfr[n], af[m], acc[m][n], 0, 0, 0); \
    } }
  static_assert(NK >= 4 && (NK & 1) == 0, "NK even, >= 4");
  GLOAD(x, 0)
  GLOAD(y, 1)
  SSTORE(x, 0, 0)
  __syncthreads();
#pragma unroll
  for (int kt = 0; kt < NK - 2; kt += 2) {
    GLOAD(x, kt + 2)
    COMPUTE(0)
    SSTORE(y, 1, kt + 1)
    __syncthreads();
    GLOAD(y, kt + 3)
    COMPUTE(1)
    SSTORE(x, 0, kt + 2)
    __syncthreads();
  }
  COMPUTE(0)
  SSTORE(y, 1, NK - 1)
  __syncthreads();
  COMPUTE(1)
  __syncthreads();
#undef GLOAD
#undef SSTORE
#undef COMPUTE
#undef GL1
#undef TABV
#undef GEN1
}
#define ACC_ZERO(a) ACC_ZERO_N(a, 4)
#define ACC_ZERO_N(a, NF_) _Pragma("unroll") for (int m_ = 0; m_ < 4; ++m_) _Pragma("unroll") for (int n_ = 0; n_ < NF_; ++n_) a[m_][n_] = (f32x4){0.f, 0.f, 0.f, 0.f}
#define EPI_BEGIN(a) EPI_BEGIN_N(a, 4)
#define EPI_BEGIN_N(a, NF_) { const int t_ = otid(), lane_ = t_ & 63, wid_ = t_ >> 6, wr_ = wid_ >> 1, wc_ = wid_ & 1; \
  _Pragma("unroll") for (int m_ = 0; m_ < 4; ++m_) _Pragma("unroll") for (int p_ = 0; p_ < NF_ / 2; ++p_) { \
    const int r = wr_ * 64 + m_ * 16 + (lane_ & 15), c = wc_ * (NF_ * 16) + p_ * 32 + (lane_ >> 4) * 8; f32x4& v0 = a[m_][2 * p_]; f32x4& v1 = a[m_][2 * p_ + 1];
#define EPI_END }}

__device__ __forceinline__ void phase_mod(const Params& P, unsigned char* smem) {
  float* sc = (float*)smem;
  float* part = (float*)(smem + 12288);
  const int tid = otid(), lane = tid & 63, w = tid >> 6;
  float* mod = (float*)(PWS + OFF_MOD);
  if (blockIdx.x >= 192) return;
  for (int i = tid; i < 3072; i += 256) {
    const int ci = i >> 10, k = i & 1023;
    const float c = ci == 0 ? P.in[I_CCTX][k] : P.in[I_C][(ci - 1) * 1024 + k];
    sc[i] = c * sigmoidf_(c);
  }
  __syncthreads();
  for (int item = blockIdx.x; item < 192; item += gridDim.x) {
    const int l = item / 96, cb = item % 96, col = cb * 64 + lane;
    const float* W = P.in[I_ADAW] + (size_t)l * 1024 * 6144 + col;
    float a0 = 0.f, a1 = 0.f, a2 = 0.f;
#pragma unroll 8
    for (int k = w * 256; k < w * 256 + 256; ++k) {
      const float wv = W[(size_t)k * 6144];
      a0 += sc[k] * wv; a1 += sc[1024 + k] * wv; a2 += sc[2048 + k] * wv;
    }
    part[(w * 3 + 0) * 64 + lane] = a0; part[(w * 3 + 1) * 64 + lane] = a1; part[(w * 3 + 2) * 64 + lane] = a2;
    __syncthreads();
    if (tid < 192) {
      const int ci = tid >> 6;
      const float s = part[(0 * 3 + ci) * 64 + lane] + part[(1 * 3 + ci) * 64 + lane] + part[(2 * 3 + ci) * 64 + lane] + part[(3 * 3 + ci) * 64 + lane];
      mod[(size_t)(l * 3 + ci) * 6144 + col] = s + P.in[I_ADAB][l * 6144 + col];
    }
    __syncthreads();
  }
}

__device__ __forceinline__ void conv_tile(const float* __restrict__ W, int N, int K, int k0, int scol0, int nvalid, bf16_t* __restrict__ dst, int drow0, float* t) {
  const int tid = otid();
#pragma unroll
  for (int i = 0; i < 16; ++i) {
    const int kk = (tid >> 6) + 4 * i, j = tid & 63;
    t[kk * 65 + j] = (j < nvalid) ? W[(size_t)(k0 + kk) * N + scol0 + j] : 0.f;
  }
  __syncthreads();
  {
    const int n = tid >> 2, kq = (tid & 3) * 16;
    uint4 o0, o1;
    const float* s = t + kq * 65 + n;
    o0.x = pk2(s[0], s[65]); o0.y = pk2(s[130], s[195]); o0.z = pk2(s[260], s[325]); o0.w = pk2(s[390], s[455]);
    s += 8 * 65;
    o1.x = pk2(s[0], s[65]); o1.y = pk2(s[130], s[195]); o1.z = pk2(s[260], s[325]); o1.w = pk2(s[390], s[455]);
    uint4* d = (uint4*)(dst + (size_t)(drow0 + n) * K + k0 + kq);
    d[0] = o0; d[1] = o1;
  }
  __syncthreads();
}
__device__ __forceinline__ void fold_tile(const float* __restrict__ W, int N, int K, int k0, int scol0, int sn, bf16_t* __restrict__ dst, int drow0, float* t, float* t2, const float* ctab) {
  const int tid = otid();
#pragma unroll
  for (int i = 0; i < 16; ++i) {
    const int kk = (tid >> 6) + 4 * i, j = tid & 63;
    t[kk * 65 + j] = W[(size_t)(k0 + kk) * N + scol0 + j];
  }
  __syncthreads();
  {
    const int j = tid & 63, kq = tid >> 6;
    float acc[16];
#pragma unroll
    for (int u = 0; u < 16; ++u) acc[u] = 0.f;
    for (int i = 0; i < 64; ++i) {
      const float tv = ctab[(i * j - (sn ? 16 : 0)) & 63];
#pragma unroll
      for (int u = 0; u < 16; ++u) acc[u] += t[(kq * 16 + u) * 65 + i] * tv;
    }
    const float scl = sn ? -0.125f : 0.125f;
#pragma unroll
    for (int u = 0; u < 16; ++u) t2[(kq * 16 + u) * 65 + j] = acc[u] * scl;
  }
  __syncthreads();
  {
    const int n = tid >> 2, kq = (tid & 3) * 16;
    uint4 o0, o1;
    const float* s = t2 + kq * 65 + n;
    o0.x = pk2(s[0], s[65]); o0.y = pk2(s[130], s[195]); o0.z = pk2(s[260], s[325]); o0.w = pk2(s[390], s[455]);
    s += 8 * 65;
    o1.x = pk2(s[0], s[65]); o1.y = pk2(s[130], s[195]); o1.z = pk2(s[260], s[325]); o1.w = pk2(s[390], s[455]);
    uint4* d = (uint4*)(dst + (size_t)(drow0 + n) * K + k0 + kq);
    d[0] = o0; d[1] = o1;
  }
  __syncthreads();
}

#define CONV_ITEMS 4256
__device__ __forceinline__ void phase_convert(const Params& P, int l, unsigned char* smem, int first, int stride) {
  float* t = (float*)smem;
  float* t2 = (float*)(smem + 16640);
  float* ctab = (float*)(smem + 33280);
  { const int tq = otid(); if (tq < 64) ctab[tq] = cosf(6.283185307179586f * (float)tq / 64.f); }
  __syncthreads();
  bf16_t* WIN = (bf16_t*)(PWS + OFF_WIN);
  for (int it = first; it < CONV_ITEMS; it += stride) {
    int r = it;
    if (r < 1696) {
      const int nt = r >> 4, kt = r & 15, np = nt * 64;
      const float* W = P.in[I_WIN] + (size_t)l * 1024 * 6432;
      if (np >= 2176 && np < 2688) {
        const int z = (np - 2176) >> 6, sn = z >> 2, g = z & 3;
        fold_tile(W, 6432, 1024, kt * 64, 256 + g * 64, sn, WIN, np, t, t2, ctab);
      } else {
        int scol, nvalid = 64;
        if (np < 256) scol = np;
        else if (np < 2080) { scol = np + 256; if (np + 64 > 2080) nvalid = 2080 - np; }
        else if (np < 2176) { scol = 0; nvalid = 0; }
        else scol = np - 352;
        conv_tile(W, 6432, 1024, kt * 64, scol, nvalid, WIN, np, t);
      }
      continue;
    }
    r -= 1696;
    if (r < 256) { conv_tile(P.in[I_WBR] + (size_t)l * 1024 * 1024, 1024, 1024, (r & 15) * 64, (r >> 4) * 64, 64, (bf16_t*)(PWS + OFF_WB), (r >> 4) * 64, t); continue; }
    r -= 256;
    if (r < 256) { conv_tile(P.in[I_WOUT] + (size_t)l * 1024 * 1024, 1024, 1024, (r & 15) * 64, (r >> 4) * 64, 64, (bf16_t*)(PWS + OFF_WO), (r >> 4) * 64, t); continue; }
    r -= 256;
    if (r < 1024) { conv_tile(P.in[I_W1] + (size_t)l * 1024 * 4096, 4096, 1024, (r & 15) * 64, (r >> 4) * 64, 64, (bf16_t*)(PWS + OFF_W1), (r >> 4) * 64, t); continue; }
    r -= 1024;
    conv_tile(P.in[I_W2] + (size_t)l * 4096 * 1024, 1024, 4096, (r & 63) * 64, (r >> 6) * 64, 64, (bf16_t*)(PWS + OFF_W2), (r >> 6) * 64, t);
  }
}
__device__ __forceinline__ void phase_table(const Params& P) {
  if (blockIdx.x == gridDim.x - 1) {
    bf16_t* tab = (bf16_t*)(PWS + OFF_TAB);
    for (int i = otid(); i < 4096; i += 256) tab[i] = f2bf(cosf(6.283185307179586f * (float)i / 4096.f));
  }
}

__device__ __forceinline__ void phase_norm(const Params& P, int l, int which) {
  const int tid = otid(), lane = tid & 63, gw = blockIdx.x * 4 + (tid >> 6), nw = gridDim.x * 4;
  const float* mod = (const float*)(PWS + OFF_MOD);
  bf16_t* H = (bf16_t*)(PWS + OFF_H);
  float omega[4] = {0.f, 0.f, 0.f, 0.f};
  if (which == 0 && l == 0) {
#pragma unroll
    for (int e = 0; e < 4; ++e) omega[e] = 1.0f / powf(10000.0f, (float)(lane * 4 + e) / 256.0f);
  }
  for (int tok = gw; tok < NT; tok += nw) {
    int start, L, ci; seq_of_tok(tok, start, L, ci);
    float* xr = P.out + (size_t)tok * 1024;
    f32x4 v[4];
    if (which == 0 && l == 0) {
      const float* src = tok < 4096 ? P.in[I_XP] + (size_t)tok * 1024 : P.in[I_XS] + (size_t)(tok - 4096) * 1024;
      const int n = tok - start;
#pragma unroll
      for (int j = 0; j < 4; ++j) {
        v[j] = *(const f32x4*)(src + j * 256 + lane * 4);
        if (tok >= 4096) {
          const float pos = (j < 2) ? (float)(n >> 6) : (float)(n & 63);
#pragma unroll
          for (int e = 0; e < 4; ++e) {
            const float ang = pos * omega[e];
            v[j][e] += (j & 1) ? cosf(ang) : sinf(ang);
          }
        }
        *(f32x4*)(xr + j * 256 + lane * 4) = v[j];
      }
    } else {
#pragma unroll
      for (int j = 0; j < 4; ++j) v[j] = *(const f32x4*)(xr + j * 256 + lane * 4);
    }
    float ss = 0.f;
#pragma unroll
    for (int j = 0; j < 4; ++j) ss += v[j][0] * v[j][0] + v[j][1] * v[j][1] + v[j][2] * v[j][2] + v[j][3] * v[j][3];
    ss = wave_sum(ss);
    const float rs = rsqrtf(ss * (1.f / 1024.f) + 1e-6f);
    if (which == 2) {
#pragma unroll
      for (int j = 0; j < 4; ++j) {
        const f32x4 g = *(const f32x4*)(P.in[I_FG] + j * 256 + lane * 4);
        f32x4 o;
#pragma unroll
        for (int e = 0; e < 4; ++e) o[e] = v[j][e] * rs * g[e];
        *(f32x4*)(xr + j * 256 + lane * 4) = o;
      }
    } else {
      const float* gsrc = (which == 0 ? P.in[I_N1G] : P.in[I_N2G]) + l * 1024;
      const float* mrow = mod + (size_t)(l * 3 + ci) * 6144 + (which == 0 ? 0 : 3072);
#pragma unroll
      for (int j = 0; j < 4; ++j) {
        const int c0 = j * 256 + lane * 4;
        const f32x4 g = *(const f32x4*)(gsrc + c0), shv = *(const f32x4*)(mrow + c0), scv = *(const f32x4*)(mrow + 1024 + c0);
        float o[4];
#pragma unroll
        for (int e = 0; e < 4; ++e) o[e] = v[j][e] * rs * g[e] * (1.f + scv[e]) + shv[e];
        uint2 pk; pk.x = pk2(o[0], o[1]); pk.y = pk2(o[2], o[3]);
        *(uint2*)(H + (size_t)tok * 1024 + c0) = pk;
      }
    }
  }
}

struct TL { int x, j, n; };
#define TILE_LOOP(NTN_) for (int q_ = tl.j, x_ = tl.x, nl_ = tl.n, NTN__ = (NTN_); q_ < 12 * (NTN_); q_ += nl_)
#ifdef TILE_STRIP
#define TILE_MT (12 * x_ + (q_ / (TILE_STRIP * NTN__)) * TILE_STRIP + q_ % TILE_STRIP)
#define TILE_NT ((q_ % (TILE_STRIP * NTN__)) / TILE_STRIP)
#else
#define TILE_MT (12 * x_ + q_ % 12)
#define TILE_NT (q_ / 12)
#endif
__device__ __forceinline__ void phase_gemm1(const Params& P, unsigned char* smem, const TL& tl) {
  const bf16_t* H = (const bf16_t*)(PWS + OFF_H);
  const bf16_t* WIN = (const bf16_t*)(PWS + OFF_WIN);
  bf16_t* U = (bf16_t*)(PWS + OFF_U);
  bf16_t* ZT = (bf16_t*)(PWS + OFF_ZT);
  TILE_LOOP(21) {
    const int mt = TILE_MT, nt = TILE_NT, m0 = mt * 128;
    f32x4 acc[4][4]; ACC_ZERO(acc);
    if (nt < 17) {
      gemm_acc<0, 4, 16>(acc, H + (size_t)m0 * 1024, 1024, WIN + (size_t)nt * 128 * 1024, 1024, smem);
      EPI_BEGIN(acc)
        uint4 pk; pk.x = pk2(v0[0], v0[1]); pk.y = pk2(v0[2], v0[3]); pk.z = pk2(v1[0], v1[1]); pk.w = pk2(v1[2], v1[3]);
        *(uint4*)(U + (size_t)(m0 + r) * NU + nt * 128 + c) = pk;
      EPI_END
    } else {
      const int z0 = (nt - 17) * 128;
      gemm_acc<0, 4, 16>(acc, WIN + (size_t)(2176 + z0) * 1024, 1024, H + (size_t)m0 * 1024, 1024, smem);
      EPI_BEGIN(acc)
        uint4 pk; pk.x = pk2(v0[0], v0[1]); pk.y = pk2(v0[2], v0[3]); pk.z = pk2(v1[0], v1[1]); pk.w = pk2(v1[2], v1[3]);
        *(uint4*)(ZT + (size_t)(z0 + r) * NT + m0 + c) = pk;
      EPI_END
    }
  }
}
__device__ __forceinline__ void phase_gemm_mlog(const Params& P, unsigned char* smem, const TL& tl) {
  const bf16_t* H = (const bf16_t*)(PWS + OFF_H);
  const bf16_t* WIN = (const bf16_t*)(PWS + OFF_WIN);
  bf16_t* Mg = (bf16_t*)(PWS + OFF_M);
  TILE_LOOP(32) {
    const int mt = TILE_MT, nt = TILE_NT, m0 = mt * 128;
    f32x4 acc[4][4]; ACC_ZERO(acc);
    gemm_acc<0, 4, 16>(acc, H + (size_t)m0 * 1024, 1024, WIN + (size_t)(2688 + nt * 128) * 1024, 1024, smem);
    EPI_BEGIN(acc)
      uint4 pk; pk.x = pk2(v0[0], v0[1]); pk.y = pk2(v0[2], v0[3]); pk.z = pk2(v1[0], v1[1]); pk.w = pk2(v1[2], v1[3]);
      *(uint4*)(Mg + (size_t)(m0 + r) * 4096 + nt * 128 + c) = pk;
    EPI_END
  }
}
__device__ __forceinline__ void phase_merge(const Params& P, unsigned char* smem, const TL& tl) {
  const bf16_t* YS = (const bf16_t*)(PWS + OFF_YS);
  const bf16_t* WB = (const bf16_t*)(PWS + OFF_WB);
  const bf16_t* Mg = (const bf16_t*)(PWS + OFF_M);
  bf16_t* MG = (bf16_t*)(PWS + OFF_U);
  TILE_LOOP(16) {
    const int mt = TILE_MT, nt = TILE_NT, m0 = mt * 128, n0 = nt * 64;
    f32x4 macc[4][2]; ACC_ZERO_N(macc, 2);
    const int t_ = otid(), lane_ = t_ & 63, wid_ = t_ >> 6, wr_ = wid_ >> 1, wc_ = wid_ & 1;
    const bf16_t* gp = Mg + (size_t)(m0 + wr_ * 64 + (lane_ & 15)) * 4096 + n0 + wc_ * 32 + (lane_ >> 4) * 8;
#define MROW(m, gX) { const uint4 gv = gX; \
      macc[m][0][0] += sigmoidf_(bflo(gv.x)) * acc[m][0][0]; macc[m][0][1] += sigmoidf_(bfhi(gv.x)) * acc[m][0][1]; \
      macc[m][0][2] += sigmoidf_(bflo(gv.y)) * acc[m][0][2]; macc[m][0][3] += sigmoidf_(bfhi(gv.y)) * acc[m][0][3]; \
      macc[m][1][0] += sigmoidf_(bflo(gv.z)) * acc[m][1][0]; macc[m][1][1] += sigmoidf_(bfhi(gv.z)) * acc[m][1][1]; \
      macc[m][1][2] += sigmoidf_(bflo(gv.w)) * acc[m][1][2]; macc[m][1][3] += sigmoidf_(bfhi(gv.w)) * acc[m][1][3]; }
#pragma unroll 1
    for (int i = 0; i < 4; ++i) {
      f32x4 acc[4][2]; ACC_ZERO_N(acc, 2);
      const uint4 g0 = *(const uint4*)(gp + i * 1024), g1 = *(const uint4*)(gp + (size_t)16 * 4096 + i * 1024),
                  g2 = *(const uint4*)(gp + (size_t)32 * 4096 + i * 1024), g3 = *(const uint4*)(gp + (size_t)48 * 4096 + i * 1024);
      gemm_acc<0, 2, 4>(acc, YS + (size_t)m0 * 1024 + i * 256, 1024, WB + (size_t)n0 * 1024 + i * 256, 1024, smem);
      MROW(0, g0) MROW(1, g1) MROW(2, g2) MROW(3, g3)
    }
#undef MROW
    EPI_BEGIN_N(macc, 2)
      uint4 pk; pk.x = pk2(v0[0], v0[1]); pk.y = pk2(v0[2], v0[3]); pk.z = pk2(v1[0], v1[1]); pk.w = pk2(v1[2], v1[3]);
      *(uint4*)(MG + (size_t)(m0 + r) * 1024 + n0 + c) = pk;
    EPI_END
  }
}
__device__ __forceinline__ void phase_gemm_res(const Params& P, int l, int which, unsigned char* smem, bool dry, const TL& tl) {
  const bf16_t* A = (const bf16_t*)(PWS + (which == 0 ? OFF_U : OFF_M));
  const bf16_t* W = (const bf16_t*)(PWS + (which == 0 ? OFF_WO : OFF_W2));
  const int K = which == 0 ? 1024 : 4096;
  const float* mod = (const float*)(PWS + OFF_MOD);
  TILE_LOOP(16) {
    const int mt = TILE_MT, nt = TILE_NT, m0 = mt * 128, n0 = nt * 64;
    int start, L, ci; seq_of_tok(m0, start, L, ci);
    const float* gate = mod + (size_t)(l * 3 + ci) * 6144 + (which == 0 ? 2048 : 5120);
    f32x4 acc[4][2]; ACC_ZERO_N(acc, 2);
    #pragma unroll 1
    for (int kc = 0; kc < K; kc += 1024) gemm_acc<0, 2, 16>(acc, A + (size_t)m0 * K + kc, K, W + (size_t)n0 * K + kc, K, smem);
    EPI_BEGIN_N(acc, 2)
      float* xp = P.out + (size_t)(m0 + r) * 1024 + n0 + c;
      const f32x4 g0 = *(const f32x4*)(gate + n0 + c), g1 = *(const f32x4*)(gate + n0 + c + 4);
      f32x4 x0 = *(const f32x4*)xp, x1 = *(const f32x4*)(xp + 4);
      x0[0] += g0[0] * v0[0]; x0[1] += g0[1] * v0[1]; x0[2] += g0[2] * v0[2]; x0[3] += g0[3] * v0[3];
      x1[0] += g1[0] * v1[0]; x1[1] += g1[1] * v1[1]; x1[2] += g1[2] * v1[2]; x1[3] += g1[3] * v1[3];
      if (!dry) { *(f32x4*)xp = x0; *(f32x4*)(xp + 4) = x1; }
    EPI_END
  }
}
__device__ __forceinline__ void phase_mlp_up(const Params& P, unsigned char* smem, const TL& tl) {
  const bf16_t* H = (const bf16_t*)(PWS + OFF_H);
  const bf16_t* W1 = (const bf16_t*)(PWS + OFF_W1);
  bf16_t* HID = (bf16_t*)(PWS + OFF_M);
  TILE_LOOP(32) {
    const int mt = TILE_MT, nt = TILE_NT, m0 = mt * 128;
    f32x4 acc[4][4]; ACC_ZERO(acc);
    gemm_acc<0, 4, 16>(acc, H + (size_t)m0 * 1024, 1024, W1 + (size_t)nt * 128 * 1024, 1024, smem);
    EPI_BEGIN(acc)
      float o[8];
#pragma unroll
      for (int e = 0; e < 4; ++e) { const float a = fmaxf(v0[e], 0.f), b = fmaxf(v1[e], 0.f); o[e] = a * a; o[4 + e] = b * b; }
      uint4 pk; pk.x = pk2(o[0], o[1]); pk.y = pk2(o[2], o[3]); pk.z = pk2(o[4], o[5]); pk.w = pk2(o[6], o[7]);
      *(uint4*)(HID + (size_t)(m0 + r) * 4096 + nt * 128 + c) = pk;
    EPI_END
  }
}

__device__ __forceinline__ void pool_tile(const Params& P, int l, int tile, unsigned char* smem) {
  const int tid = otid(), tok0 = tile * 32;
  int start, L, ci; seq_of_tok(tok0, start, L, ci);
  const bf16_t* U = (const bf16_t*)(PWS + OFF_U);
  bf16_t* YS = (bf16_t*)(PWS + OFF_YS);
  float* pl = (float*)smem;
  bf16_t* zw = (bf16_t*)(smem + 32768);
  float* tw = (float*)(smem + 32768);
  float* ca = (float*)(smem + 49152);
  const int col = tid, g = col >> 6;
#pragma unroll
  for (int i = 0; i < 6; ++i) {
    const int c = tid + 256 * i;
    if (c < 47 * 32) {
      const int rr = c >> 5, cc = (c & 31) * 8, t = tok0 - 8 + rr - start;
      uint4 v = make_uint4(0u, 0u, 0u, 0u);
      if (t >= 0 && t < L) v = *(const uint4*)(U + (size_t)(start + t) * NU + UP + cc);
      *(uint4*)(zw + rr * 256 + cc) = v;
    }
  }
  __syncthreads();
  {
    const int half = 1 << g, win = 2 << g;
#pragma unroll 4
    for (int tt = 0; tt < 32; ++tt) {
      const int t = tok0 + tt - start;
      const int lo = max(t - half, 0), hi = min(t + half - 1, L - 1);
      float s = 0.f;
      const bf16_t* zp = zw + (tt + 8 - half) * 256 + col;
      for (int p = 0; p < win; ++p) s += bf2f(zp[p * 256]);
      pl[tt * 256 + col] = s / (float)(hi - lo + 1) - bf2f(zw[(tt + 8) * 256 + col]);
    }
  }
  __syncthreads();
  {
    float wreg[64];
    const float* pw = P.in[I_POOLW] + (size_t)(l * 4 + g) * 4096 + (col & 63);
#pragma unroll
    for (int cc = 0; cc < 64; ++cc) wreg[cc] = pw[cc * 64];
    const float ps = P.in[I_POOLS][l * 256 + col];
#pragma unroll 2
    for (int tt = 0; tt < 32; ++tt) {
      float a0 = 0.f, a1 = 0.f;
#pragma unroll
      for (int c4 = 0; c4 < 16; ++c4) {
        const f32x4 p4 = *(const f32x4*)(pl + tt * 256 + g * 64 + c4 * 4);
        a0 += p4[0] * wreg[c4 * 4] + p4[2] * wreg[c4 * 4 + 2];
        a1 += p4[1] * wreg[c4 * 4 + 1] + p4[3] * wreg[c4 * 4 + 3];
      }
      YS[(size_t)(tok0 + tt) * 1024 + col] = f2bf((a0 + a1) * ps);
    }
  }
  __syncthreads();
}
__device__ __forceinline__ void prep_tile(const Params& P, int l, int tile, unsigned char* smem) {
  const int tid = otid(), tok0 = tile * 32;
  int start, L, ci; seq_of_tok(tok0, start, L, ci);
  const bf16_t* U = (const bf16_t*)(PWS + OFF_U);
  bf16_t* YS = (bf16_t*)(PWS + OFF_YS);
  float* pl = (float*)smem;
  bf16_t* zw = (bf16_t*)(smem + 32768);
  float* tw = (float*)(smem + 32768);
  float* ca = (float*)(smem + 49152);
  const int col = tid, g = col >> 6;
#pragma unroll
  for (int i = 0; i < 3; ++i) {
    const int c = tid + 256 * i, tt = c / 24, j8 = (c % 24) * 8;
    const uint4 v = *(const uint4*)(U + (size_t)(tok0 + tt) * NU + UCW + j8);
    const unsigned w4[4] = {v.x, v.y, v.z, v.w};
#pragma unroll
    for (int e2 = 0; e2 < 4; ++e2) {
      const float x0 = bflo(w4[e2]), x1 = bfhi(w4[e2]);
      const int jj = j8 + 2 * e2;
      if (jj < 128) { tw[tt * 128 + jj] = 1.f - 2.f * __frcp_rn(1.f + __expf(2.f * x0)); tw[tt * 128 + jj + 1] = 1.f - 2.f * __frcp_rn(1.f + __expf(2.f * x1)); }
      else { ca[tt * 64 + jj - 128] = x0; ca[tt * 64 + jj - 127] = x1; }
    }
  }
  __syncthreads();
  float* Wd = (float*)(PWS + OFF_M + M_W);
  float aF[32], aB[32];
#pragma unroll 1
  for (int dir = 0; dir < 2; ++dir) {
    {
      float wreg[64];
      const float* bw = P.in[I_BW] + (size_t)(l * 2 + dir) * 64 * 256 + col;
#pragma unroll
      for (int r = 0; r < 64; ++r) wreg[r] = bw[r * 256];
      const float w0 = P.in[I_W0][(l * 2 + dir) * 256 + col];
#pragma unroll 2
      for (int tt = 0; tt < 32; ++tt) {
        float a0 = w0, a1 = 0.f;
#pragma unroll
        for (int r4 = 0; r4 < 16; ++r4) {
          const f32x4 x4 = *(const f32x4*)(tw + tt * 128 + dir * 64 + r4 * 4);
          a0 += x4[0] * wreg[r4 * 4] + x4[2] * wreg[r4 * 4 + 2];
          a1 += x4[1] * wreg[r4 * 4 + 1] + x4[3] * wreg[r4 * 4 + 3];
        }
        Wd[((size_t)dir * NT + tok0 + tt) * 256 + col] = __expf(-0.606531f * sigmoidf_(a0 + a1));
      }
    }
    {
      float wreg[32];
      const float* ba = P.in[I_BA] + (size_t)(l * 2 + dir) * 32 * 256 + col;
#pragma unroll
      for (int r = 0; r < 32; ++r) wreg[r] = ba[r * 256];
      const float a0c = P.in[I_A0][(l * 2 + dir) * 256 + col];
#pragma unroll
      for (int tt = 0; tt < 32; ++tt) {
        float a0 = a0c, a1 = 0.f;
#pragma unroll
        for (int r4 = 0; r4 < 8; ++r4) {
          const f32x4 x4 = *(const f32x4*)(ca + tt * 64 + dir * 32 + r4 * 4);
          a0 += x4[0] * wreg[r4 * 4] + x4[2] * wreg[r4 * 4 + 2];
          a1 += x4[1] * wreg[r4 * 4 + 1] + x4[3] * wreg[r4 * 4 + 3];
        }
        const float a = sigmoidf_(a0 + a1);
        if (dir == 0) aF[tt] = a; else aB[tt] = a;
      }
    }
  }
  {
    bf16_t* Rr = (bf16_t*)(PWS + OFF_M + M_R);
    bf16_t* Vv = (bf16_t*)(PWS + OFF_M + M_V);
    bf16_t* KKn = (bf16_t*)(PWS + OFF_M + M_KK);
    bf16_t* KD = (bf16_t*)(PWS + OFF_M + M_KD);
    bf16_t* Bb = (bf16_t*)(PWS + OFF_M + M_B);
    float* ORW = (float*)(PWS + OFF_ORW);
    const float mur = P.in[I_MU][l * 768 + col], muk = P.in[I_MU][l * 768 + 256 + col], muv = P.in[I_MU][l * 768 + 512 + col];
    const float kkp = P.in[I_KKP][l * 256 + col], ka = P.in[I_KA][l * 256 + col];
#pragma unroll
    for (int tt = 0; tt < 32; ++tt) {
      const int tok = tok0 + tt, t = tok - start;
      const bf16_t* u0 = U + (size_t)tok * NU;
      const float zr = bf2f(u0[UR + col]), zk = bf2f(u0[UK + col]), zv = bf2f(u0[UV + col]);
      float pr = 0.f, pk = 0.f, pv = 0.f, nr = 0.f, nk = 0.f, nv = 0.f;
      if (t > 0) { pr = bf2f(u0[UR + col - NU]); pk = bf2f(u0[UK + col - NU]); pv = bf2f(u0[UV + col - NU]); }
      if (t < L - 1) { nr = bf2f(u0[UR + col + NU]); nk = bf2f(u0[UK + col + NU]); nv = bf2f(u0[UV + col + NU]); }
      const float r = zr + mur * (0.5f * (pr + nr) - zr);
      const float k = zk + muk * (0.5f * (pk + nk) - zk);
      const float v = zv + muv * (0.5f * (pv + nv) - zv);
      float kk = k * kkp;
      const float ss = wave_sum(kk * kk);
      kk *= rsqrtf(ss + 1e-6f);
      const size_t o = (size_t)tok * 256 + col;
      Rr[o] = f2bf(r); Vv[o] = f2bf(v); KKn[o] = f2bf(kk);
      KD[o] = f2bf(k * (1.f + (aF[tt] - 1.f) * ka)); KD[(size_t)NT * 256 + o] = f2bf(k * (1.f + (aB[tt] - 1.f) * ka));
      Bb[o] = f2bf(kk * aF[tt]); Bb[(size_t)NT * 256 + o] = f2bf(kk * aB[tt]);
      ORW[o] = 0.f;
    }
  }
  __syncthreads();
}

__device__ __forceinline__ void gla_bcum(const Params& P, int l, int dir, int h, int c0, float* gs) {
  const int tid = otid();
  const bf16_t* U = (const bf16_t*)(PWS + OFF_U);
  {
    const int pp = tid >> 2, dq = tid & 3, tok = dir ? c0 + 63 - pp : c0 + pp;
    const uint4* cp = (const uint4*)(U + (size_t)tok * NU + UCAL + dir * 16);
    const uint4 c0v = cp[0], c1v = cp[1];
    float cal[16];
    cal[0] = bflo(c0v.x); cal[1] = bfhi(c0v.x); cal[2] = bflo(c0v.y); cal[3] = bfhi(c0v.y); cal[4] = bflo(c0v.z); cal[5] = bfhi(c0v.z); cal[6] = bflo(c0v.w); cal[7] = bfhi(c0v.w);
    cal[8] = bflo(c1v.x); cal[9] = bfhi(c1v.x); cal[10] = bflo(c1v.y); cal[11] = bfhi(c1v.y); cal[12] = bflo(c1v.z); cal[13] = bfhi(c1v.z); cal[14] = bflo(c1v.w); cal[15] = bfhi(c1v.w);
    const float* ab = P.in[I_GAB] + (size_t)(l * 2 + dir) * 16 * 128 + h * 32 + dq * 8;
    const float* bias = P.in[I_GABIAS] + (l * 2 + dir) * 128 + h * 32 + dq * 8;
#pragma unroll
    for (int dd = 0; dd < 8; ++dd) {
      float x = bias[dd];
#pragma unroll
      for (int r = 0; r < 16; ++r) x += cal[r] * ab[r * 128 + dd];
      const float ls = fminf(x, 0.f) - __logf(1.f + __expf(-fabsf(x)));
      gs[pp * 32 + dq * 8 + dd] = ls * (1.f / 16.f);
    }
  }
  __syncthreads();
  {
    float* segs = gs + 10240;
    const int d = tid & 31, sg_ = tid >> 5;
    float v[8], run = 0.f;
#pragma unroll
    for (int i = 0; i < 8; ++i) { run += gs[(sg_ * 8 + i) * 32 + d]; v[i] = run; }
    segs[sg_ * 32 + d] = run;
    __syncthreads();
    float off = 0.f;
#pragma unroll
    for (int s2 = 0; s2 < 7; ++s2) off += (s2 < sg_) ? segs[s2 * 32 + d] : 0.f;
#pragma unroll
    for (int i = 0; i < 8; ++i) gs[(sg_ * 8 + i) * 32 + d] = v[i] + off;
  }
  __syncthreads();
}
__device__ __forceinline__ void gla_g1(const Params& P, int l, int item, unsigned char* smem) {
  const int tid = otid();
  const int dir = item & 1, h = (item >> 1) & 3, cgi = item >> 3, c0 = cgi * 64;
  const bf16_t* U = (const bf16_t*)(PWS + OFF_U);
  float* gs = (float*)smem;
  float* kt = (float*)(smem + 8192);
  float* vs = (float*)(smem + 16384);
  gla_bcum(P, l, dir, h, c0, gs);
  {
    const int pp = tid >> 2, q4 = tid & 3, tok = dir ? c0 + 63 - pp : c0 + pp;
    const uint4 kv = *(const uint4*)(U + (size_t)tok * NU + UGK + h * 32 + q4 * 8);
    const unsigned kw[4] = {kv.x, kv.y, kv.z, kv.w};
#pragma unroll
    for (int i = 0; i < 4; ++i) {
      const int d = q4 * 8 + 2 * i;
      kt[pp * 32 + d] = bflo(kw[i]) * __expf(gs[63 * 32 + d] - gs[pp * 32 + d]);
      kt[pp * 32 + d + 1] = bfhi(kw[i]) * __expf(gs[63 * 32 + d + 1] - gs[pp * 32 + d + 1]);
    }
    const uint4* vp = (const uint4*)(U + (size_t)tok * NU + UGV + h * 64 + q4 * 16);
    const uint4 v0 = vp[0], v1 = vp[1];
    const unsigned vw[8] = {v0.x, v0.y, v0.z, v0.w, v1.x, v1.y, v1.z, v1.w};
#pragma unroll
    for (int i = 0; i < 8; ++i) { vs[pp * 64 + q4 * 16 + 2 * i] = bflo(vw[i]); vs[pp * 64 + q4 * 16 + 2 * i + 1] = bfhi(vw[i]); }
  }
  __syncthreads();
  {
    const int e = tid & 63, dq = tid >> 6;
    float acc[8];
#pragma unroll
    for (int dd = 0; dd < 8; ++dd) acc[dd] = 0.f;
    for (int pp = 0; pp < 64; ++pp) {
      const float vv = vs[pp * 64 + e];
#pragma unroll
      for (int dd = 0; dd < 8; ++dd) acc[dd] += kt[pp * 32 + dq * 8 + dd] * vv;
    }
    float* S = (float*)(PWS + OFF_M + M_GS) + (size_t)item * 2080;
#pragma unroll
    for (int dd = 0; dd < 8; ++dd) S[(dq * 8 + dd) * 64 + e] = acc[dd];
    if (tid < 32) S[2048 + tid] = __expf(gs[63 * 32 + tid]);
  }
  __syncthreads();
}
__device__ __forceinline__ void gla_g2(const Params& P, int l, int item, unsigned char* smem) {
  const int tid = otid();
  const int h = item & 3, cgi = item >> 2, c0 = cgi * 64;
  int start, L, ci; seq_of_tok(c0, start, L, ci);
  const int cfirst = start >> 6, nc = L >> 6;
  const bf16_t* U = (const bf16_t*)(PWS + OFF_U);
  const float* GS = (const float*)(PWS + OFF_M + M_GS);
  float* gs = (float*)smem;
  float* qt = (float*)(smem + 8192);
  float* kt = (float*)(smem + 16384);
  float* vs = (float*)(smem + 24576);
  float* att = (float*)(smem + 40960);
  float* Sp = (float*)(smem + 57600);
  const int e = tid & 63, pq = tid >> 6;
  float oacc[16];
#pragma unroll
  for (int i = 0; i < 16; ++i) oacc[i] = 0.f;
#pragma unroll 1
  for (int dir = 0; dir < 2; ++dir) {
    gla_bcum(P, l, dir, h, c0, gs);
    {
      float S[8];
      if (ci == 0) {
#pragma unroll
        for (int dd = 0; dd < 8; ++dd) S[dd] = 0.f;
      } else {
        const float* s0 = P.in[I_SGL] + ((((size_t)(ci - 1) * 2 + l) * 2 + dir) * 4 + h) * 2048;
#pragma unroll
        for (int dd = 0; dd < 8; ++dd) S[dd] = s0[(pq * 8 + dd) * 64 + e];
      }
      if (dir == 0) {
        for (int j = cfirst; j < cgi; ++j) {
          const float* sj = GS + (size_t)((j * 4 + h) * 2 + 0) * 2080;
#pragma unroll
          for (int dd = 0; dd < 8; ++dd) S[dd] = sj[2048 + pq * 8 + dd] * S[dd] + sj[(pq * 8 + dd) * 64 + e];
        }
      } else {
        for (int j = cfirst + nc - 1; j > cgi; --j) {
          const float* sj = GS + (size_t)((j * 4 + h) * 2 + 1) * 2080;
#pragma unroll
          for (int dd = 0; dd < 8; ++dd) S[dd] = sj[2048 + pq * 8 + dd] * S[dd] + sj[(pq * 8 + dd) * 64 + e];
        }
      }
#pragma unroll
      for (int dd = 0; dd < 8; ++dd) Sp[(pq * 8 + dd) * 64 + e] = S[dd];
      const bool last = dir == 0 ? (cgi == cfirst + nc - 1) : (cgi == cfirst);
      if (ci == 0 && last) {
        const float* sj = GS + (size_t)((cgi * 4 + h) * 2 + dir) * 2080;
        const int b = start >> 8;
        float* dst = P.out + OUT_SG + ((((size_t)b * 2 + l) * 2 + dir) * 4 + h) * 2048;
#pragma unroll
        for (int dd = 0; dd < 8; ++dd) dst[(pq * 8 + dd) * 64 + e] = sj[2048 + pq * 8 + dd] * S[dd] + sj[(pq * 8 + dd) * 64 + e];
      }
    }
    {
      const int pp = tid >> 2, q4 = tid & 3, tok = dir ? c0 + 63 - pp : c0 + pp;
      const uint4 qv = *(const uint4*)(U + (size_t)tok * NU + UGQ + h * 32 + q4 * 8);
      const uint4 kv = *(const uint4*)(U + (size_t)tok * NU + UGK + h * 32 + q4 * 8);
      const unsigned qw[4] = {qv.x, qv.y, qv.z, qv.w};
      const unsigned kw[4] = {kv.x, kv.y, kv.z, kv.w};
#pragma unroll
      for (int i = 0; i < 4; ++i) {
        const int d = q4 * 8 + 2 * i;
        const float b0 = gs[pp * 32 + d], b1 = gs[pp * 32 + d + 1];
        qt[pp * 32 + d] = bflo(qw[i]) * 0.17677669529663687f * __expf(b0);
        qt[pp * 32 + d + 1] = bfhi(qw[i]) * 0.17677669529663687f * __expf(b1);
        kt[pp * 32 + d] = bflo(kw[i]) * __expf(-b0);
        kt[pp * 32 + d + 1] = bfhi(kw[i]) * __expf(-b1);
      }
      const uint4* vp = (const uint4*)(U + (size_t)tok * NU + UGV + h * 64 + q4 * 16);
      const uint4 v0 = vp[0], v1 = vp[1];
      const unsigned vw[8] = {v0.x, v0.y, v0.z, v0.w, v1.x, v1.y, v1.z, v1.w};
#pragma unroll
      for (int i = 0; i < 8; ++i) { vs[pp * 64 + q4 * 16 + 2 * i] = bflo(vw[i]); vs[pp * 64 + q4 * 16 + 2 * i + 1] = bfhi(vw[i]); }
    }
    __syncthreads();
    {
      const int pp = tid >> 2, sq = tid & 3;
      float qr[32];
#pragma unroll
      for (int d = 0; d < 32; ++d) qr[d] = qt[pp * 32 + d];
#pragma unroll 1
      for (int si = 0; si < 16; ++si) {
        const int s = sq * 16 + si;
        float a = 0.f;
        if (s <= pp) {
#pragma unroll
          for (int d = 0; d < 32; ++d) a += qr[d] * kt[s * 32 + d];
        }
        att[pp * 65 + s] = a;
      }
    }
    __syncthreads();
    {
#pragma unroll 2
      for (int s = 0; s < 64; ++s) {
        const float vv = vs[s * 64 + e];
#pragma unroll
        for (int i = 0; i < 16; ++i) { const int tau = pq * 16 + i, pp = dir ? 63 - tau : tau; oacc[i] += att[pp * 65 + s] * vv; }
      }
#pragma unroll 2
      for (int d = 0; d < 32; ++d) {
        const float sv = Sp[d * 64 + e];
#pragma unroll
        for (int i = 0; i < 16; ++i) { const int tau = pq * 16 + i, pp = dir ? 63 - tau : tau; oacc[i] += qt[pp * 32 + d] * sv; }
      }
    }
    __syncthreads();
  }
  {
    bf16_t* YS = (bf16_t*)(PWS + OFF_YS);
    const float gnorm = P.in[I_GNORM][l * 256 + h * 64 + e];
#pragma unroll
    for (int i = 0; i < 16; ++i) {
      const size_t tok = (size_t)(c0 + pq * 16 + i);
      const float og = oacc[i];
      const float ms = wave_sum(og * og) * (1.f / 64.f);
      const float go = bf2f(U[tok * NU + UGO + h * 64 + e]);
      YS[tok * 1024 + 768 + h * 64 + e] = f2bf(og * rsqrtf(ms + 1e-6f) * gnorm * (go * sigmoidf_(go)));
    }
  }
}

#define SC_BUF 22528
__device__ __forceinline__ void rwkv_scan(const Params& P, int l, int item, bool dry, unsigned char* smem) {
  const int tid = otid();
  int seq, sub;
  if (item < 64) { seq = 16 + (item >> 5); sub = item & 31; } else { seq = (item - 64) >> 5; sub = (item - 64) & 31; }
  const int h = sub >> 3, dir = (sub >> 2) & 1, rg = sub & 3;
  const int start = seq < 16 ? seq * 256 : 4096 + (seq - 16) * 4096, L = seq < 16 ? 256 : 4096;
  const int rowl = tid >> 4, j = tid & 15, row = rg * 16 + rowl;
  unsigned char* ws = PWS;
  const float* Wd = (const float*)(ws + OFF_M + M_W) + (size_t)dir * NT * 256 + h * 64 + j * 4;
  const bf16_t* KD = (const bf16_t*)(ws + OFF_M + M_KD) + (size_t)dir * NT * 256 + h * 64 + j * 4;
  const bf16_t* Bb = (const bf16_t*)(ws + OFF_M + M_B) + (size_t)dir * NT * 256 + h * 64 + j * 4;
  const bf16_t* Rr = (const bf16_t*)(ws + OFF_M + M_R) + h * 64 + j * 4;
  const bf16_t* KKn = (const bf16_t*)(ws + OFF_M + M_KK) + h * 64 + j * 4;
  const bf16_t* Vv = (const bf16_t*)(ws + OFF_M + M_V) + h * 64 + rg * 16 + j;
  float* ORW = (float*)(ws + OFF_ORW) + h * 64 + rg * 16 + j;
  typedef float f32x2 __attribute__((ext_vector_type(2)));
  f32x2 S01, S23;
  if (seq < 16) {
    S01 = (f32x2){0.f, 0.f}; S23 = (f32x2){0.f, 0.f};
  } else {
    const f32x4 s0 = *(const f32x4*)(P.in[I_SRW] + (((((size_t)(seq - 16) * 2 + l) * 2 + dir) * 4 + h) * 64 + row) * 64 + j * 4);
    S01 = (f32x2){s0[0], s0[1]}; S23 = (f32x2){s0[2], s0[3]};
  }
  f32x4 gw; uint2 gkd, gb, gkk, gr; unsigned gv;
  const int nch = L >> 4;
#define SC_TOK(c_) ((size_t)(start + (dir ? L - 1 - ((c_) * 16 + rowl) : (c_) * 16 + rowl)))
#define SC_LOAD(c_) { const size_t tk = SC_TOK(c_) * 256; gw = *(const f32x4*)(Wd + tk); gkd = *(const uint2*)(KD + tk); gb = *(const uint2*)(Bb + tk); \
    gkk = *(const uint2*)(KKn + tk); gr = *(const uint2*)(Rr + tk); gv = Vv[tk]; }
#define SC_STORE(b_) { float* base = (float*)(smem + (b_) * SC_BUF) + rowl * 64 + j * 4; \
    *(f32x4*)(base) = gw; \
    *(f32x4*)(base + 1024) = (f32x4){bflo(gkd.x), bfhi(gkd.x), bflo(gkd.y), bfhi(gkd.y)}; \
    *(f32x4*)(base + 2048) = (f32x4){bflo(gb.x), bfhi(gb.x), bflo(gb.y), bfhi(gb.y)}; \
    *(f32x4*)(base + 3072) = (f32x4){bflo(gkk.x), bfhi(gkk.x), bflo(gkk.y), bfhi(gkk.y)}; \
    *(f32x4*)(base + 4096) = (f32x4){bflo(gr.x), bfhi(gr.x), bflo(gr.y), bfhi(gr.y)}; \
    ((float*)(smem + (b_) * SC_BUF + 20480))[j * 16 + rowl] = __uint_as_float(gv << 16); }
  SC_LOAD(0)
  SC_STORE(0)
  if (nch > 1) SC_LOAD(1)
  __syncthreads();
#pragma unroll 1
  for (int c = 0; c < nch; ++c) {
    const float* buf = (const float*)(smem + (c & 1) * SC_BUF);
    float* outl = (float*)(smem + (c & 1) * SC_BUF + 21504);
    float myout = 0.f;
    f32x4 v4[4];
#pragma unroll
    for (int i = 0; i < 4; ++i) v4[i] = *(const f32x4*)(buf + 5120 + rowl * 16 + i * 4);
    f32x4 w4 = *(const f32x4*)(buf + j * 4), kd4 = *(const f32x4*)(buf + 1024 + j * 4), b4 = *(const f32x4*)(buf + 2048 + j * 4),
          kk4 = *(const f32x4*)(buf + 3072 + j * 4), r4 = *(const f32x4*)(buf + 4096 + j * 4);
    float dot;
    {
      f32x2 p = S01 * (f32x2){kk4[0], kk4[1]};
      p = S23 * (f32x2){kk4[2], kk4[3]} + p;
      dot = row16_sum(p[0] + p[1]);
    }
#pragma unroll
    for (int s = 0; s < 16; ++s) {
      f32x4 w4n, kd4n, b4n, kk4n, r4n;
      if (s < 15) {
        w4n = *(const f32x4*)(buf + (s + 1) * 64 + j * 4);
        kd4n = *(const f32x4*)(buf + 1024 + (s + 1) * 64 + j * 4);
        b4n = *(const f32x4*)(buf + 2048 + (s + 1) * 64 + j * 4);
        kk4n = *(const f32x4*)(buf + 3072 + (s + 1) * 64 + j * 4);
        r4n = *(const f32x4*)(buf + 4096 + (s + 1) * 64 + j * 4);
      }
      __builtin_amdgcn_sched_barrier(0);
      const float vf = v4[s >> 2][s & 3];
      const f32x2 t01 = S01 * (f32x2){w4[0], w4[1]} + (f32x2){kd4[0], kd4[1]} * vf;
      const f32x2 t23 = S23 * (f32x2){w4[2], w4[3]} + (f32x2){kd4[2], kd4[3]} * vf;
      S01 = t01 - (f32x2){b4[0], b4[1]} * dot;
      S23 = t23 - (f32x2){b4[2], b4[3]} * dot;
      f32x2 o = S01 * (f32x2){r4[0], r4[1]};
      o = S23 * (f32x2){r4[2], r4[3]} + o;
      float od = o[0] + o[1];
      if (s < 15) {
        f32x2 p = S01 * (f32x2){kk4n[0], kk4n[1]};
        p = S23 * (f32x2){kk4n[2], kk4n[3]} + p;
        float dn = p[0] + p[1];
        row16_sum2(dn, od);
        dot = dn;
        w4 = w4n; kd4 = kd4n; b4 = b4n; kk4 = kk4n; r4 = r4n;
      } else {
        od = row16_sum(od);
      }
      myout = (j == s) ? od : myout;
    }
    outl[j * 16 + rowl] = myout;
    if (c + 1 < nch) SC_STORE((c + 1) & 1)
    __syncthreads();
    if (!dry) __hip_atomic_fetch_add(ORW + SC_TOK(c) * 256, outl[rowl * 16 + j], __ATOMIC_RELAXED, __HIP_MEMORY_SCOPE_AGENT);
    if (c + 2 < nch) SC_LOAD(c + 2)
  }
#undef SC_TOK
#undef SC_LOAD
#undef SC_STORE
  if (seq < 16 && !dry) {
    f32x4 o; o[0] = S01[0]; o[1] = S01[1]; o[2] = S23[0]; o[3] = S23[1];
    *(f32x4*)(P.out + OUT_SR + (((((size_t)seq * 2 + l) * 2 + dir) * 4 + h) * 64 + row) * 64 + j * 4) = o;
  }
  __syncthreads();
}

__device__ __forceinline__ void fourier_tile(const Params& P, int item, unsigned char* smem) {
  int seq, mt, nt;
  if (item < 128) { seq = 16 + (item >> 6); mt = (item >> 1) & 31; nt = item & 1; }
  else { const int r = item - 128; seq = r >> 2; mt = (r >> 1) & 1; nt = r & 1; }
  const int start = seq < 16 ? seq * 256 : 4096 + (seq - 16) * 4096, L = seq < 16 ? 256 : 4096, sh = seq < 16 ? 4 : 0;
  const bf16_t* ZT = (const bf16_t*)(PWS + OFF_ZT);
  bf16_t* YS = (bf16_t*)(PWS + OFF_YS);
  f32x4 acc[4][4]; ACC_ZERO(acc);
  if (seq < 16) {
    gemm_acc<1, 4, 4>(acc, nullptr, 0, ZT + (size_t)(nt * 128) * NT + start, NT, smem, mt * 128, 255, 4, 0, 0);
    gemm_acc<1, 4, 4>(acc, nullptr, 0, ZT + (size_t)(256 + nt * 128) * NT + start, NT, smem, mt * 128, 255, 4, 3072, 0);
  } else {
#pragma unroll 1
    for (int pass = 0; pass < 8; ++pass) {
      const int nb = (pass & 3) * 1024, sn = pass >> 2;
      gemm_acc<1, 4, 16>(acc, nullptr, 0, ZT + (size_t)(sn * 256 + nt * 128) * NT + start + nb, NT, smem, mt * 128, 4095, 0, sn ? 3072 : 0, nb);
    }
  }
  const float scl = seq < 16 ? 0.0625f : 0.015625f;
  EPI_BEGIN(acc)
    uint4 pk; pk.x = pk2(v0[0] * scl, v0[1] * scl); pk.y = pk2(v0[2] * scl, v0[3] * scl); pk.z = pk2(v1[0] * scl, v1[1] * scl); pk.w = pk2(v1[2] * scl, v1[3] * scl);
    *(uint4*)(YS + (size_t)(start + mt * 128 + r) * 1024 + 256 + nt * 128 + c) = pk;
  EPI_END
}

#define CT 24
__device__ __forceinline__ void combine_tile(const Params& P, int l, int tile, unsigned char* smem) {
  const int tid = otid(), tok0 = tile * CT, col = tid;
  const bf16_t* U = (const bf16_t*)(PWS + OFF_U);
  bf16_t* YS = (bf16_t*)(PWS + OFF_YS);
  float* sg = (float*)smem;
  for (int i = tid; i < CT * 64; i += 256) sg[i] = sigmoidf_(bf2f(U[(size_t)(tok0 + (i >> 6)) * NU + UCG + (i & 63)]));
  __syncthreads();
  float gate[CT];
  {
    float wreg[64];
    const float* bg = P.in[I_BG] + (size_t)l * 64 * 256 + col;
#pragma unroll
    for (int r = 0; r < 64; ++r) wreg[r] = bg[r * 256];
#pragma unroll
    for (int tt = 0; tt < CT; ++tt) {
      float a0 = 0.f, a1 = 0.f;
#pragma unroll
      for (int r4 = 0; r4 < 16; ++r4) {
        const f32x4 x4 = *(const f32x4*)(sg + tt * 64 + r4 * 4);
        a0 += x4[0] * wreg[r4 * 4] + x4[2] * wreg[r4 * 4 + 2];
        a1 += x4[1] * wreg[r4 * 4 + 1] + x4[3] * wreg[r4 * 4 + 3];
      }
      gate[tt] = a0 + a1;
    }
  }
  const bf16_t* Rr = (const bf16_t*)(PWS + OFF_M + M_R);
  const bf16_t* Vv = (const bf16_t*)(PWS + OFF_M + M_V);
  const bf16_t* KD = (const bf16_t*)(PWS + OFF_M + M_KD);
  const float* ORW = (const float*)(PWS + OFF_ORW);
  const float gn = P.in[I_GN][l * 256 + col], rk = P.in[I_RK][l * 256 + col];
#pragma unroll
  for (int tt = 0; tt < CT; ++tt) {
    const size_t o = (size_t)(tok0 + tt) * 256 + col;
    const float ov = ORW[o];
    const float mu = wave_sum(ov) * (1.f / 64.f);
    const float dv = ov - mu;
    const float var = wave_sum(dv * dv) * (1.f / 64.f);
    const float on = dv * rsqrtf(var + 64e-5f) * gn;
    const float r = bf2f(Rr[o]), v = bf2f(Vv[o]);
    const float kds = bf2f(KD[o]) + bf2f(KD[(size_t)NT * 256 + o]);
    const float bonus = wave_sum(r * kds * rk);
    const float yc = (on + bonus * v) * gate[tt];
    YS[(size_t)(tok0 + tt) * 1024 + 512 + col] = f2bf(yc);
  }
  __syncthreads();
}


#define OFF_BAR WS_END
#define XB_TMO      128
#define XB_XCNT(j)  (256  + 64 * (j))
#define XB_XSUB(j)  (1280 + 64 * (j))
#define XB_XGEN(j)  (2304 + 64 * (j))
#define XB_TOP      3328
#define XB_TOPGEN   3392
#define XCD_BAR_WORDS 3456
#define XB_SPIN_CAP (1u << 18)
#define LAS __attribute__((address_space(3)))

__device__ __forceinline__ unsigned xb_ld(unsigned* p)              { return __hip_atomic_load(p, __ATOMIC_RELAXED, __HIP_MEMORY_SCOPE_AGENT); }
__device__ __forceinline__ unsigned xb_add(unsigned* p, unsigned v) { return __hip_atomic_fetch_add(p, v, __ATOMIC_RELAXED, __HIP_MEMORY_SCOPE_AGENT); }
__device__ __forceinline__ unsigned xb_xcc_id() { return (unsigned)__builtin_amdgcn_s_getreg((3 << 11) | 20) & 0xFu; }
#define XB_SPIN(cond, bar) do { unsigned _sp = 0; while (cond) { __builtin_amdgcn_s_sleep(1); \
    if ((++_sp & 255u) == 0u) { if (xb_ld(&(bar)[XB_TMO])) break; if (_sp > XB_SPIN_CAP) { atomicAdd(&(bar)[XB_TMO], 1u); break; } } } } while (0)

struct XcdBarrier {
    unsigned* bar; unsigned x;
    volatile LAS unsigned* st;
};

__device__ __forceinline__ XcdBarrier xcd_barrier_post(unsigned* bar, volatile LAS unsigned* st) {
    XcdBarrier b; b.bar = bar; b.x = xb_xcc_id(); b.st = st;
    if (otid() == 0) st[2] = xb_add(&bar[XB_XCNT(b.x)], 1u);
    return b;
}
__device__ __forceinline__ void xcd_barrier_complete(unsigned* bar, unsigned x, unsigned& nloc, unsigned& nx) {
    const unsigned G = gridDim.x * gridDim.y * gridDim.z;
    unsigned sum, cnt, mine, sp = 0u;
    for (;;) {
        sum = 0u; cnt = 0u; mine = 0u;
#pragma unroll
        for (unsigned j = 0; j < 16; ++j) { const unsigned c = xb_ld(&bar[XB_XCNT(j)]); sum += c; cnt += (c > 0u) ? 1u : 0u; mine = (j == x) ? c : mine; }
        if (sum == G) break;
        __builtin_amdgcn_s_sleep(1);
        if ((++sp & 255u) == 0u) { if (xb_ld(&bar[XB_TMO])) break; if (sp > XB_SPIN_CAP) { atomicAdd(&bar[XB_TMO], 1u); break; } }
    }
    nloc = mine > 0u ? mine : 1u; nx = cnt > 0u ? cnt : 1u;
}

__device__ __forceinline__ void xcd_barrier(const XcdBarrier& b) {
    asm volatile("s_waitcnt vmcnt(0)" ::: "memory");
    __syncthreads();
    if (otid() == 0) {
        unsigned* bar = b.bar;
        __builtin_amdgcn_s_waitcnt(0);
        unsigned nloc = b.st[0], nx = b.st[1];
        if (nloc == 0u) { xcd_barrier_complete(bar, b.x, nloc, nx); b.st[0] = nloc; b.st[1] = nx; }
        const unsigned old = xb_add(&bar[XB_XSUB(b.x)], 1u);
        const unsigned gen = old / nloc;
        if (old + 1u == (gen + 1u) * nloc) {
            __builtin_amdgcn_fence(__ATOMIC_RELEASE, "agent");
            asm volatile("s_waitcnt vmcnt(0)" ::: "memory");
            const unsigned og = xb_add(&bar[XB_TOP], 1u);
            const unsigned tg = og / nx;
            if (og + 1u == (tg + 1u) * nx) xb_add(&bar[XB_TOPGEN], 1u);
            else XB_SPIN(xb_ld(&bar[XB_TOPGEN]) == tg, bar);
            __builtin_amdgcn_fence(__ATOMIC_ACQUIRE, "agent");
            xb_add(&bar[XB_XGEN(b.x)], 1u);
            asm volatile("s_waitcnt vmcnt(0)" ::: "memory");
        } else {
            XB_SPIN(xb_ld(&bar[XB_XGEN(b.x)]) == gen, bar);
            __builtin_amdgcn_fence(__ATOMIC_ACQUIRE, "agent");
            asm volatile("s_waitcnt vmcnt(0)" ::: "memory");
        }
    }
    __syncthreads();
}
#define gsync(P_, e_) xcd_barrier(xb)

#ifndef R_P0
#define R_P0 1
#endif
#ifndef R_NORM
#define R_NORM 1
#endif
#ifndef R_GEMM
#define R_GEMM 1
#endif
#ifndef R_PREP
#define R_PREP 1
#endif
#ifndef R_SCAN
#define R_SCAN 1
#endif
#ifndef R_FOUR
#define R_FOUR 1
#endif
#ifndef R_G2
#define R_G2 1
#endif
#define REP(n) for (int rep = 0; rep < 1; ++rep)
__global__ void __launch_bounds__(256, 2) mega(Params P) {
  extern __shared__ __attribute__((aligned(16))) unsigned char smem[];
  cg::grid_group grid = cg::this_grid();
  const int G = gridDim.x;
  unsigned epoch = 0;
  int zero = 0; asm volatile("" : "+s"(zero));
  volatile LAS unsigned* xst = (volatile LAS unsigned*)(LAS unsigned char*)(smem + LDS_BYTES - 16);
  if (otid() == 0) { xst[0] = 0u; xst[1] = 0u; }
  __syncthreads();
  XcdBarrier xb = xcd_barrier_post((unsigned*)(PWS + OFF_BAR), xst);
  grid.sync();
  REP(R_P0) {
    phase_mod(P, smem);
    __syncthreads();
    phase_table(P);
    {
      const int nb = G > 256 ? G - 192 : G;
      if (G > 256) { if ((int)blockIdx.x >= 192) phase_convert(P, 0, smem, blockIdx.x - 192, nb); }
      else phase_convert(P, 0, smem, blockIdx.x, nb);
    }
  }
  gsync(P, epoch);
  TL tl;
  {
    const unsigned nloc = xst[0], nx = xst[1], jl = xst[2];
    if (nx == 8u && xb.x < 8u && nloc > 0u) { tl.x = (int)xb.x; tl.j = (int)jl; tl.n = (int)nloc; }
    else { tl.x = blockIdx.x & 7; tl.j = blockIdx.x >> 3; tl.n = G >> 3; }
  }
#pragma unroll 1
  for (int l = 0; l < 2; ++l) {
    REP(R_NORM) {
      if (l == 1) phase_convert(P, 1, smem, blockIdx.x, G);
      phase_norm(P, l, 0);
    }
    gsync(P, epoch);
    REP(R_GEMM) phase_gemm1(P, smem, tl);
#ifdef DUP_GEMM
    phase_gemm1(P, smem, tl);
#endif
    gsync(P, epoch);
    if (G > 384 + 64) {
      if ((int)blockIdx.x < 384) prep_tile(P, l, blockIdx.x, smem);
      else for (int it = blockIdx.x - 384; it < 1536; it += G - 384) gla_g1(P, l, it, smem);
    } else {
      for (int it = blockIdx.x; it < 384 + 1536; it += G) {
        if (it < 384) prep_tile(P, l, it, smem); else gla_g1(P, l, it - 384, smem);
      }
    }
#ifdef DUP_PREP
    for (int it = blockIdx.x; it < 384; it += G) prep_tile(P, l, it, smem);
#endif
#ifdef DUP_G1
    for (int it = blockIdx.x + 384; it < 384 + 1536; it += G) gla_g1(P, l, it - 384, smem);
#endif
    gsync(P, epoch);
    {
      const bf16_t* tabg = (const bf16_t*)(PWS + OFF_TAB);
      bf16_t* tabl = (bf16_t*)(smem + LDS_TAB);
      for (int i = otid(); i < 4096; i += 256) tabl[i] = tabg[i];
      __syncthreads();
      if (G >= 256) {
        const int b = blockIdx.x;
        const bool is_scan = b < 128 && (b & 8) == 0;
        if (is_scan) rwkv_scan(P, l, (b >> 4) * 8 + (b & 7), false, smem);
        else {
          const int ob = b < 128 ? (b >> 4) * 8 + (b & 7) : b - 64;
          for (int it = 64 + ob; it < 576 + 192 + 768 + 384; it += G - 64) {
            if (it < 576) rwkv_scan(P, l, it, false, smem);
            else if (it < 768) fourier_tile(P, it - 576, smem);
            else if (it < 1536) gla_g2(P, l, it - 768, smem);
            else pool_tile(P, l, it - 1536, smem);
          }
        }
      } else {
        for (int it = blockIdx.x; it < 576 + 192 + 768 + 384; it += G) {
          if (it < 576) rwkv_scan(P, l, it, false, smem);
          else if (it < 768) fourier_tile(P, it - 576, smem);
          else if (it < 1536) gla_g2(P, l, it - 768, smem);
          else pool_tile(P, l, it - 1536, smem);
        }
      }
    }
    gsync(P, epoch);
    REP(R_PREP) for (int it = blockIdx.x; it < NT / CT; it += G) combine_tile(P, l, it, smem);
#ifdef DUP_COMB
    for (int it = blockIdx.x; it < 384; it += G) combine_tile(P, l, it, smem);
#endif
    gsync(P, epoch);
    REP(R_GEMM) phase_gemm_mlog(P, smem, tl);
#ifdef DUP_GEMM
    phase_gemm_mlog(P, smem, tl);
#endif
    gsync(P, epoch);
    REP(R_GEMM) phase_merge(P, smem, tl);
#ifdef DUP_GEMM
    phase_merge(P, smem, tl);
#endif
    gsync(P, epoch);
    REP(R_GEMM) phase_gemm_res(P, l, 0, smem, rep > 0, tl);
    gsync(P, epoch);
    REP(R_NORM) phase_norm(P, l, 1);
    gsync(P, epoch);
    REP(R_GEMM) phase_mlp_up(P, smem, tl);
#ifdef DUP_GEMM
    phase_mlp_up(P, smem, tl);
#endif
    gsync(P, epoch);
    REP(R_GEMM) phase_gemm_res(P, l, 1, smem, rep > 0, tl);
    gsync(P, epoch);
  }
#ifdef R_SYNC
  for (int i = 0; i < R_SYNC + zero; ++i) gsync(P, epoch);
#endif
  phase_norm(P, 0, 2);
}

extern "C" void kernel_launch(void* const* d_in, const int* in_sizes, int n_in, void* d_out, int out_size, void* d_ws, size_t ws_size,
                              hipStream_t stream) {
  static int grid_blocks = 0;
  if (!grid_blocks) {
    int dev = 0, cus = 0, per_cu = 0;
    hipGetDevice(&dev);
    hipDeviceGetAttribute(&cus, hipDeviceAttributeMultiprocessorCount, dev);
    hipFuncSetAttribute((const void*)mega, hipFuncAttributeMaxDynamicSharedMemorySize, LDS_BYTES);
    hipOccupancyMaxActiveBlocksPerMultiprocessor(&per_cu, (const void*)mega, 256, LDS_BYTES);
    per_cu = 2;
    grid_blocks = cus * per_cu;
    if (ws_size < WS_END) fprintf(stderr, "kernel_launch: workspace too small: %zu < %llu\n", ws_size, (unsigned long long)WS_END);
  }
  Params p{};
  for (int i = 0; i < 31; ++i) p.in[i] = (const float*)d_in[i];
  p.out = (float*)d_out;
  p.ws_ = (unsigned char*)d_ws;
  hipMemsetAsync((unsigned char*)d_ws + OFF_BAR, 0, XCD_BAR_WORDS * 4, stream);
  void* args[] = {&p};
  hipError_t e = hipLaunchCooperativeKernel((const void*)mega, dim3(grid_blocks), dim3(256), args, LDS_BYTES, stream);
  if (e != hipSuccess) fprintf(stderr, "cooperative launch failed: %s (grid %d)\n", hipGetErrorString(e), grid_blocks);
}
```

```cpp
#define TILE_STRIP 6
#include <hip/hip_runtime.h>
#include <hip/hip_cooperative_groups.h>
#include <cstdio>
#include <cstdint>
namespace cg = cooperative_groups;

typedef unsigned short bf16_t;
typedef short bf16x8 __attribute__((ext_vector_type(8)));
typedef float f32x4 __attribute__((ext_vector_type(4)));

#define NT 12288
#define DM 1024
#define NU 2176
#define NWIN 6784
#define DFF 4096
#define UP 0
#define UR 256
#define UK 512
#define UV 768
#define UCW 1024
#define UCA 1152
#define UCG 1216
#define UGQ 1280
#define UGK 1408
#define UGV 1536
#define UGO 1792
#define UCAL 2048

#define OFF_MOD 0ull
#define OFF_TAB 147456ull
#define OFF_WIN 155648ull
#define OFF_WB 14049280ull
#define OFF_WO 16146432ull
#define OFF_W1 18243584ull
#define OFF_W2 26632192ull
#define OFF_H 35020800ull
#define OFF_U 60186624ull
#define OFF_ZT 113664000ull
#define OFF_YS 126246912ull
#define OFF_ORW 151412736ull
#define OFF_M 163995648ull
#define WS_END 264658944ull
#define M_R 0ull
#define M_V 6291456ull
#define M_KK 12582912ull
#define M_KD 18874368ull
#define M_B 31457280ull
#define M_W 44040192ull
#define M_OG 69206016ull
#define M_GS 81788928ull

#define OUT_SR 12582912ull
#define OUT_SG 13631488ull

#define LDS_BYTES 74256
#define LDS_TAB 66048

struct Params {
  const float* in[31];
  float* out;
  unsigned char* ws_;
};
enum { I_XP = 0, I_XS, I_SRW, I_SGL, I_C, I_CCTX, I_ADAW, I_ADAB, I_N1G, I_N2G, I_WIN, I_POOLW, I_POOLS, I_MU, I_W0, I_BW,
       I_A0, I_BA, I_KKP, I_KA, I_BG, I_RK, I_GN, I_GAB, I_GABIAS, I_GNORM, I_WBR, I_WOUT, I_W1, I_W2, I_FG };

__device__ __forceinline__ bf16_t f2bf(float f) {
  unsigned u = __float_as_uint(f);
  u += 0x7fffu + ((u >> 16) & 1u);
  return (bf16_t)(u >> 16);
}
__device__ __forceinline__ float bf2f(bf16_t h) { return __uint_as_float(((unsigned)h) << 16); }
__device__ __forceinline__ unsigned pk2(float a, float b) { return (unsigned)f2bf(a) | ((unsigned)f2bf(b) << 16); }
__device__ __forceinline__ float bflo(unsigned u) { return __uint_as_float(u << 16); }
__device__ __forceinline__ float bfhi(unsigned u) { return __uint_as_float(u & 0xffff0000u); }
__device__ __forceinline__ float sigmoidf_(float x) { return __frcp_rn(1.f + __expf(-x)); }
__device__ __forceinline__ float row16_sum(float v);
__device__ __forceinline__ float wave_sum(float v) {
  v = row16_sum(v);
  const int iv = __builtin_bit_cast(int, v);
  const float s0 = __builtin_bit_cast(float, __builtin_amdgcn_readlane(iv, 0)), s1 = __builtin_bit_cast(float, __builtin_amdgcn_readlane(iv, 16));
  const float s2 = __builtin_bit_cast(float, __builtin_amdgcn_readlane(iv, 32)), s3 = __builtin_bit_cast(float, __builtin_amdgcn_readlane(iv, 48));
  return (s0 + s1) + (s2 + s3);
}
__device__ __forceinline__ float row16_sum(float v) {
  v += __builtin_bit_cast(float, __builtin_amdgcn_update_dpp(0, __builtin_bit_cast(int, v), 0x128, 0xf, 0xf, false));
  v += __builtin_bit_cast(float, __builtin_amdgcn_update_dpp(0, __builtin_bit_cast(int, v), 0x124, 0xf, 0xf, false));
  v += __builtin_bit_cast(float, __builtin_amdgcn_update_dpp(0, __builtin_bit_cast(int, v), 0x122, 0xf, 0xf, false));
  v += __builtin_bit_cast(float, __builtin_amdgcn_update_dpp(0, __builtin_bit_cast(int, v), 0x121, 0xf, 0xf, false));
  return v;
}
#define DPP_ADD(v_, ctrl_) v_ += __builtin_bit_cast(float, __builtin_amdgcn_update_dpp(0, __builtin_bit_cast(int, v_), ctrl_, 0xf, 0xf, false))
__device__ __forceinline__ void row16_sum2(float& a, float& b) {
  DPP_ADD(a, 0x128); DPP_ADD(b, 0x128); DPP_ADD(a, 0x124); DPP_ADD(b, 0x124); DPP_ADD(a, 0x122); DPP_ADD(b, 0x122); DPP_ADD(a, 0x121); DPP_ADD(b, 0x121);
}
__device__ __forceinline__ void seq_of_tok(int tok, int& start, int& L, int& ci) {
  if (tok < 4096) { start = tok & ~255; L = 256; ci = 0; }
  else { int b = (tok - 4096) >> 12; start = 4096 + (b << 12); L = 4096; ci = 1 + b; }
}

__device__ __forceinline__ size_t oz0() { size_t z = 0; asm volatile("" : "+s"(z)); return z; }
#define PWS (P.ws_ + oz0())
__device__ __forceinline__ int otid() { int t = threadIdx.x; asm volatile("" : "+v"(t)); return t; }
template <int AMODE, int NF, int NK>
__device__ __forceinline__ void gemm_acc(f32x4 (&acc)[4][NF], const bf16_t* __restrict__ A, int lda, const bf16_t* __restrict__ B, int ldb,
                                         unsigned char* smem, int k1base = 0, int Lmask = 0, int sh = 0, int ph = 0, int nbase = 0) {
  const int tid = otid(), lane = tid & 63, wid = tid >> 6, wr = wid >> 1, wc = wid & 1;
  bf16_t* sA = (bf16_t*)smem;
  bf16_t* sB = (bf16_t*)(smem + 32768);
  const bf16_t* tab = (const bf16_t*)(smem + LDS_TAB);
  uint4 ra0x, ra1x, ra2x, ra3x, rb0x, rb1x, rb2x, rb3x, ra0y, ra1y, ra2y, ra3y, rb0y, rb1y, rb2y, rb3y;
  const int row0 = tid >> 3, kc0 = tid & 7;
  const int soff = row0 * 64 + ((kc0 ^ ((row0 >> 1) & 7)) << 3);
  const int rho0 = (((row0 >> 2) & 1) << 4) | ((row0 >> 3) << 2) | (row0 & 3);
  const int soffB = rho0 * 64 + ((kc0 ^ ((rho0 >> 1) & 7)) << 3);
  const bf16_t* Ap = A + (size_t)row0 * lda + kc0 * 8;
  const bf16_t* Bp = B + (size_t)row0 * ldb + kc0 * 8;
#define GL1(r_, P_, ld_, i_, kt_) r_ = *(const uint4*)(P_ + (size_t)(32 * i_) * ld_ + (kt_) * 64);
#define GLOAD(X, kt) { if (AMODE == 0) { GL1(ra0##X, Ap, lda, 0, kt) GL1(ra1##X, Ap, lda, 1, kt) GL1(ra2##X, Ap, lda, 2, kt) GL1(ra3##X, Ap, lda, 3, kt) } \
    GL1(rb0##X, Bp, ldb, 0, kt) GL1(rb1##X, Bp, ldb, 1, kt) if (NF == 4) { GL1(rb2##X, Bp, ldb, 2, kt) GL1(rb3##X, Bp, ldb, 3, kt) } }
#define TABV(dst_) { const unsigned lo = tab[((idx << sh) + ph) & 4095]; idx = (idx + k1) & Lmask; const unsigned hi = tab[((idx << sh) + ph) & 4095]; idx = (idx + k1) & Lmask; dst_ = lo | (hi << 16); }
#define GEN1(r_, i_, kt_) { const int k1 = k1base + row0 + 32 * i_, n = nbase + (kt_) * 64 + kc0 * 8; int idx = (k1 * n) & Lmask; TABV(r_.x) TABV(r_.y) TABV(r_.z) TABV(r_.w) }
#define SSTORE(X, buf, kt) { if (AMODE == 1) { GEN1(ra0##X, 0, kt) GEN1(ra1##X, 1, kt) GEN1(ra2##X, 2, kt) GEN1(ra3##X, 3, kt) } \
    *(uint4*)(sA + (buf) * 8192 + soff) = ra0##X; *(uint4*)(sA + (buf) * 8192 + soff + 2048) = ra1##X; *(uint4*)(sA + (buf) * 8192 + soff + 4096) = ra2##X; *(uint4*)(sA + (buf) * 8192 + soff + 6144) = ra3##X; \
    *(uint4*)(sB + (buf) * 8192 + soffB) = rb0##X; *(uint4*)(sB + (buf) * 8192 + soffB + 2048) = rb1##X; \
    if (NF == 4) { *(uint4*)(sB + (buf) * 8192 + soffB + 4096) = rb2##X; *(uint4*)(sB + (buf) * 8192 + soffB + 6144) = rb3##X; } }
#define COMPUTE(buf) { \
    _Pragma("unroll") for (int ks = 0; ks < 2; ++ks) { \
      bf16x8 af[4], bfr[NF]; \
      const int q = ks * 4 + (lane >> 4); \
      _Pragma("unroll") for (int m = 0; m < 4; ++m) { const int r = wr * 64 + m * 16 + (lane & 15); af[m] = *(const bf16x8*)(sA + (buf) * 8192 + r * 64 + ((q ^ ((r >> 1) & 7)) << 3)); } \
      _Pragma("unroll") for (int n = 0; n < NF; ++n) { const int r = wc * (NF * 16) + n * 16 + (lane & 15); bfr[n] = *(const bf16x8*)(sB + (buf) * 8192 + r * 64 + ((q ^ ((r >> 1) & 7)) << 3)); } \
      _Pragma("unroll") for (int m = 0; m < 4; ++m) \
        _Pragma("unroll") for (int n = 0; n < NF; ++n) acc[m][n] = __builtin_amdgcn_mfma_f32_16x16x32_bf16(bfr[n], af[m], acc[m][n], 0, 0, 0); \
    } }
  static_assert(NK >= 4 && (NK & 1) == 0, "NK even, >= 4");
  GLOAD(x, 0)
  GLOAD(y, 1)
  SSTORE(x, 0, 0)
  __syncthreads();
#pragma unroll
  for (int kt = 0; kt < NK - 2; kt += 2) {
    GLOAD(x, kt + 2)
    COMPUTE(0)
    SSTORE(y, 1, kt + 1)
    __syncthreads();
    GLOAD(y, kt + 3)
    COMPUTE(1)
    SSTORE(x, 0, kt + 2)
    __syncthreads();
  }
  COMPUTE(0)
  SSTORE(y, 1, NK - 1)
  __syncthreads();
  COMPUTE(1)
  __syncthreads();
#undef GLOAD
#undef SSTORE
#undef COMPUTE
#undef GL1
#undef TABV
#undef GEN1
}
#define ACC_ZERO(a) ACC_ZERO_N(a, 4)
#define ACC_ZERO_N(a, NF_) _Pragma("unroll") for (int m_ = 0; m_ < 4; ++m_) _Pragma("unroll") for (int n_ = 0; n_ < NF_; ++n_) a[m_][n_] = (f32x4){0.f, 0.f, 0.f, 0.f}
#define EPI_BEGIN(a) EPI_BEGIN_N(a, 4)
#define EPI_BEGIN_N(a, NF_) { const int t_ = otid(), lane_ = t_ & 63, wid_ = t_ >> 6, wr_ = wid_ >> 1, wc_ = wid_ & 1; \
  _Pragma("unroll") for (int m_ = 0; m_ < 4; ++m_) _Pragma("unroll") for (int p_ = 0; p_ < NF_ / 2; ++p_) { \
    const int r = wr_ * 64 + m_ * 16 + (lane_ & 15), c = wc_ * (NF_ * 16) + p_ * 32 + (lane_ >> 4) * 8; f32x4& v0 = a[m_][2 * p_]; f32x4& v1 = a[m_][2 * p_ + 1];
#define EPI_END }}

__device__ __forceinline__ void phase_mod(const Params& P, unsigned char* smem) {
  float* sc = (float*)smem;
  float* part = (float*)(smem + 12288);
  const int tid = otid(), lane = tid & 63, w = tid >> 6;
  float* mod = (float*)(PWS + OFF_MOD);
  if (blockIdx.x >= 192) return;
  for (int i = tid; i < 3072; i += 256) {
    const int ci = i >> 10, k = i & 1023;
    const float c = ci == 0 ? P.in[I_CCTX][k] : P.in[I_C][(ci - 1) * 1024 + k];
    sc[i] = c * sigmoidf_(c);
  }
  __syncthreads();
  for (int item = blockIdx.x; item < 192; item += gridDim.x) {
    const int l = item / 96, cb = item % 96, col = cb * 64 + lane;
    const float* W = P.in[I_ADAW] + (size_t)l * 1024 * 6144 + col;
    float a0 = 0.f, a1 = 0.f, a2 = 0.f;
#pragma unroll 8
    for (int k = w * 256; k < w * 256 + 256; ++k) {
      const float wv = W[(size_t)k * 6144];
      a0 += sc[k] * wv; a1 += sc[1024 + k] * wv; a2 += sc[2048 + k] * wv;
    }
    part[(w * 3 + 0) * 64 + lane] = a0; part[(w * 3 + 1) * 64 + lane] = a1; part[(w * 3 + 2) * 64 + lane] = a2;
    __syncthreads();
    if (tid < 192) {
      const int ci = tid >> 6;
      const float s = part[(0 * 3 + ci) * 64 + lane] + part[(1 * 3 + ci) * 64 + lane] + part[(2 * 3 + ci) * 64 + lane] + part[(3 * 3 + ci) * 64 + lane];
      mod[(size_t)(l * 3 + ci) * 6144 + col] = s + P.in[I_ADAB][l * 6144 + col];
    }
    __syncthreads();
  }
}

__device__ __forceinline__ void conv_tile(const float* __restrict__ W, int N, int K, int k0, int scol0, int nvalid, bf16_t* __restrict__ dst, int drow0, float* t) {
  const int tid = otid();
#pragma unroll
  for (int i = 0; i < 16; ++i) {
    const int kk = (tid >> 6) + 4 * i, j = tid & 63;
    t[kk * 65 + j] = (j < nvalid) ? W[(size_t)(k0 + kk) * N + scol0 + j] : 0.f;
  }
  __syncthreads();
  {
    const int n = tid >> 2, kq = (tid & 3) * 16;
    uint4 o0, o1;
    const float* s = t + kq * 65 + n;
    o0.x = pk2(s[0], s[65]); o0.y = pk2(s[130], s[195]); o0.z = pk2(s[260], s[325]); o0.w = pk2(s[390], s[455]);
    s += 8 * 65;
    o1.x = pk2(s[0], s[65]); o1.y = pk2(s[130], s[195]); o1.z = pk2(s[260], s[325]); o1.w = pk2(s[390], s[455]);
    uint4* d = (uint4*)(dst + (size_t)(drow0 + n) * K + k0 + kq);
    d[0] = o0; d[1] = o1;
  }
  __syncthreads();
}
__device__ __forceinline__ void fold_tile(const float* __restrict__ W, int N, int K, int k0, int scol0, int sn, bf16_t* __restrict__ dst, int drow0, float* t, float* t2, const float* ctab) {
  const int tid = otid();
#pragma unroll
  for (int i = 0; i < 16; ++i) {
    const int kk = (tid >> 6) + 4 * i, j = tid & 63;
    t[kk * 65 + j] = W[(size_t)(k0 + kk) * N + scol0 + j];
  }
  __syncthreads();
  {
    const int j = tid & 63, kq = tid >> 6;
    float acc[16];
#pragma unroll
    for (int u = 0; u < 16; ++u) acc[u] = 0.f;
    for (int i = 0; i < 64; ++i) {
      const float tv = ctab[(i * j - (sn ? 16 : 0)) & 63];
#pragma unroll
      for (int u = 0; u < 16; ++u) acc[u] += t[(kq * 16 + u) * 65 + i] * tv;
    }
    const float scl = sn ? -0.125f : 0.125f;
#pragma unroll
    for (int u = 0; u < 16; ++u) t2[(kq * 16 + u) * 65 + j] = acc[u] * scl;
  }
  __syncthreads();
  {
    const int n = tid >> 2, kq = (tid & 3) * 16;
    uint4 o0, o1;
    const float* s = t2 + kq * 65 + n;
    o0.x = pk2(s[0], s[65]); o0.y = pk2(s[130], s[195]); o0.z = pk2(s[260], s[325]); o0.w = pk2(s[390], s[455]);
    s += 8 * 65;
    o1.x = pk2(s[0], s[65]); o1.y = pk2(s[130], s[195]); o1.z = pk2(s[260], s[325]); o1.w = pk2(s[390], s[455]);
    uint4* d = (uint4*)(dst + (size_t)(drow0 + n) * K + k0 + kq);
    d[0] = o0; d[1] = o1;
  }
  __syncthreads();
}

#define CONV_ITEMS 4256
__device__ __forceinline__ void phase_convert(const Params& P, int l, unsigned char* smem, int first, int stride) {
  float* t = (float*)smem;
  float* t2 = (float*)(smem + 16640);
  float* ctab = (float*)(smem + 33280);
  { const int tq = otid(); if (tq < 64) ctab[tq] = cosf(6.283185307179586f * (float)tq / 64.f); }
  __syncthreads();
  bf16_t* WIN = (bf16_t*)(PWS + OFF_WIN);
  for (int it = first; it < CONV_ITEMS; it += stride) {
    int r = it;
    if (r < 1696) {
      const int nt = r >> 4, kt = r & 15, np = nt * 64;
      const float* W = P.in[I_WIN] + (size_t)l * 1024 * 6432;
      if (np >= 2176 && np < 2688) {
        const int z = (np - 2176) >> 6, sn = z >> 2, g = z & 3;
        fold_tile(W, 6432, 1024, kt * 64, 256 + g * 64, sn, WIN, np, t, t2, ctab);
      } else {
        int scol, nvalid = 64;
        if (np < 256) scol = np;
        else if (np < 2080) { scol = np + 256; if (np + 64 > 2080) nvalid = 2080 - np; }
        else if (np < 2176) { scol = 0; nvalid = 0; }
        else scol = np - 352;
        conv_tile(W, 6432, 1024, kt * 64, scol, nvalid, WIN, np, t);
      }
      continue;
    }
    r -= 1696;
    if (r < 256) { conv_tile(P.in[I_WBR] + (size_t)l * 1024 * 1024, 1024, 1024, (r & 15) * 64, (r >> 4) * 64, 64, (bf16_t*)(PWS + OFF_WB), (r >> 4) * 64, t); continue; }
    r -= 256;
    if (r < 256) { conv_tile(P.in[I_WOUT] + (size_t)l * 1024 * 1024, 1024, 1024, (r & 15) * 64, (r >> 4) * 64, 64, (bf16_t*)(PWS + OFF_WO), (r >> 4) * 64, t); continue; }
    r -= 256;
    if (r < 1024) { conv_tile(P.in[I_W1] + (size_t)l * 1024 * 4096, 4096, 1024, (r & 15) * 64, (r >> 4) * 64, 64, (bf16_t*)(PWS + OFF_W1), (r >> 4) * 64, t); continue; }
    r -= 1024;
    conv_tile(P.in[I_W2] + (size_t)l * 4096 * 1024, 1024, 4096, (r & 63) * 64, (r >> 6) * 64, 64, (bf16_t*)(PWS + OFF_W2), (r >> 6) * 64, t);
  }
}
__device__ __forceinline__ void phase_table(const Params& P) {
  if (blockIdx.x == gridDim.x - 1) {
    bf16_t* tab = (bf16_t*)(PWS + OFF_TAB);
    for (int i = otid(); i < 4096; i += 256) tab[i] = f2bf(cosf(6.283185307179586f * (float)i / 4096.f));
  }
}

__device__ __forceinline__ void phase_norm(const Params& P, int l, int which) {
  const int tid = otid(), lane = tid & 63, gw = blockIdx.x * 4 + (tid >> 6), nw = gridDim.x * 4;
  const float* mod = (const float*)(PWS + OFF_MOD);
  bf16_t* H = (bf16_t*)(PWS + OFF_H);
  float omega[4] = {0.f, 0.f, 0.f, 0.f};
  if (which == 0 && l == 0) {
#pragma unroll
    for (int e = 0; e < 4; ++e) omega[e] = 1.0f / powf(10000.0f, (float)(lane * 4 + e) / 256.0f);
  }
  for (int tok = gw; tok < NT; tok += nw) {
    int start, L, ci; seq_of_tok(tok, start, L, ci);
    float* xr = P.out + (size_t)tok * 1024;
    f32x4 v[4];
    if (which == 0 && l == 0) {
      const float* src = tok < 4096 ? P.in[I_XP] + (size_t)tok * 1024 : P.in[I_XS] + (size_t)(tok - 4096) * 1024;
      const int n = tok - start;
#pragma unroll
      for (int j = 0; j < 4; ++j) {
        v[j] = *(const f32x4*)(src + j * 256 + lane * 4);
        if (tok >= 4096) {
          const float pos = (j < 2) ? (float)(n >> 6) : (float)(n & 63);
#pragma unroll
          for (int e = 0; e < 4; ++e) {
            const float ang = pos * omega[e];
            v[j][e] += (j & 1) ? cosf(ang) : sinf(ang);
          }
        }
        *(f32x4*)(xr + j * 256 + lane * 4) = v[j];
      }
    } else {
#pragma unroll
      for (int j = 0; j < 4; ++j) v[j] = *(const f32x4*)(xr + j * 256 + lane * 4);
    }
    float ss = 0.f;
#pragma unroll
    for (int j = 0; j < 4; ++j) ss += v[j][0] * v[j][0] + v[j][1] * v[j][1] + v[j][2] * v[j][2] + v[j][3] * v[j][3];
    ss = wave_sum(ss);
    const float rs = rsqrtf(ss * (1.f / 1024.f) + 1e-6f);
    if (which == 2) {
#pragma unroll
      for (int j = 0; j < 4; ++j) {
        const f32x4 g = *(const f32x4*)(P.in[I_FG] + j * 256 + lane * 4);
        f32x4 o;
#pragma unroll
        for (int e = 0; e < 4; ++e) o[e] = v[j][e] * rs * g[e];
        *(f32x4*)(xr + j * 256 + lane * 4) = o;
      }
    } else {
      const float* gsrc = (which == 0 ? P.in[I_N1G] : P.in[I_N2G]) + l * 1024;
      const float* mrow = mod + (size_t)(l * 3 + ci) * 6144 + (which == 0 ? 0 : 3072);
#pragma unroll
      for (int j = 0; j < 4; ++j) {
        const int c0 = j * 256 + lane * 4;
        const f32x4 g = *(const f32x4*)(gsrc + c0), shv = *(const f32x4*)(mrow + c0), scv = *(const f32x4*)(mrow + 1024 + c0);
        float o[4];
#pragma unroll
        for (int e = 0; e < 4; ++e) o[e] = v[j][e] * rs * g[e] * (1.f + scv[e]) + shv[e];
        uint2 pk; pk.x = pk2(o[0], o[1]); pk.y = pk2(o[2], o[3]);
        *(uint2*)(H + (size_t)tok * 1024 + c0) = pk;
      }
    }
  }
}

struct TL { int x, j, n; };
#define TILE_LOOP(NTN_) for (int q_ = tl.j, x_ = tl.x, nl_ = tl.n, NTN__ = (NTN_); q_ < 12 * (NTN_); q_ += nl_)
#ifdef TILE_STRIP
#define TILE_MT (12 * x_ + (q_ / (TILE_STRIP * NTN__)) * TILE_STRIP + q_ % TILE_STRIP)
#define TILE_NT ((q_ % (TILE_STRIP * NTN__)) / TILE_STRIP)
#else
#define TILE_MT (12 * x_ + q_ % 12)
#define TILE_NT (q_ / 12)
#endif
__device__ __forceinline__ void phase_gemm1(const Params& P, unsigned char* smem, const TL& tl) {
  const bf16_t* H = (const bf16_t*)(PWS + OFF_H);
  const bf16_t* WIN = (const bf16_t*)(PWS + OFF_WIN);
  bf16_t* U = (bf16_t*)(PWS + OFF_U);
  bf16_t* ZT = (bf16_t*)(PWS + OFF_ZT);
  TILE_LOOP(21) {
    const int mt = TILE_MT, nt = TILE_NT, m0 = mt * 128;
    f32x4 acc[4][4]; ACC_ZERO(acc);
    if (nt < 17) {
      gemm_acc<0, 4, 16>(acc, H + (size_t)m0 * 1024, 1024, WIN + (size_t)nt * 128 * 1024, 1024, smem);
      EPI_BEGIN(acc)
        uint4 pk; pk.x = pk2(v0[0], v0[1]); pk.y = pk2(v0[2], v0[3]); pk.z = pk2(v1[0], v1[1]); pk.w = pk2(v1[2], v1[3]);
        *(uint4*)(U + (size_t)(m0 + r) * NU + nt * 128 + c) = pk;
      EPI_END
    } else {
      const int z0 = (nt - 17) * 128;
      gemm_acc<0, 4, 16>(acc, WIN + (size_t)(2176 + z0) * 1024, 1024, H + (size_t)m0 * 1024, 1024, smem);
      EPI_BEGIN(acc)
        uint4 pk; pk.x = pk2(v0[0], v0[1]); pk.y = pk2(v0[2], v0[3]); pk.z = pk2(v1[0], v1[1]); pk.w = pk2(v1[2], v1[3]);
        *(uint4*)(ZT + (size_t)(z0 + r) * NT + m0 + c) = pk;
      EPI_END
    }
  }
}
__device__ __forceinline__ void phase_gemm_mlog(const Params& P, unsigned char* smem, const TL& tl) {
  const bf16_t* H = (const bf16_t*)(PWS + OFF_H);
  const bf16_t* WIN = (const bf16_t*)(PWS + OFF_WIN);
  bf16_t* Mg = (bf16_t*)(PWS + OFF_M);
  TILE_LOOP(32) {
    const int mt = TILE_MT, nt = TILE_NT, m0 = mt * 128;
    f32x4 acc[4][4]; ACC_ZERO(acc);
    gemm_acc<0, 4, 16>(acc, H + (size_t)m0 * 1024, 1024, WIN + (size_t)(2688 + nt * 128) * 1024, 1024, smem);
    EPI_BEGIN(acc)
      uint4 pk; pk.x = pk2(v0[0], v0[1]); pk.y = pk2(v0[2], v0[3]); pk.z = pk2(v1[0], v1[1]); pk.w = pk2(v1[2], v1[3]);
      *(uint4*)(Mg + (size_t)(m0 + r) * 4096 + nt * 128 + c) = pk;
    EPI_END
  }
}
__device__ __forceinline__ void phase_merge(const Params& P, unsigned char* smem, const TL& tl) {
  const bf16_t* YS = (const bf16_t*)(PWS + OFF_YS);
  const bf16_t* WB = (const bf16_t*)(PWS + OFF_WB);
  const bf16_t* Mg = (const bf16_t*)(PWS + OFF_M);
  bf16_t* MG = (bf16_t*)(PWS + OFF_U);
  TILE_LOOP(16) {
    const int mt = TILE_MT, nt = TILE_NT, m0 = mt * 128, n0 = nt * 64;
    f32x4 macc[4][2]; ACC_ZERO_N(macc, 2);
    const int t_ = otid(), lane_ = t_ & 63, wid_ = t_ >> 6, wr_ = wid_ >> 1, wc_ = wid_ & 1;
    const bf16_t* gp = Mg + (size_t)(m0 + wr_ * 64 + (lane_ & 15)) * 4096 + n0 + wc_ * 32 + (lane_ >> 4) * 8;
#define MROW(m, gX) { const uint4 gv = gX; \
      macc[m][0][0] += sigmoidf_(bflo(gv.x)) * acc[m][0][0]; macc[m][0][1] += sigmoidf_(bfhi(gv.x)) * acc[m][0][1]; \
      macc[m][0][2] += sigmoidf_(bflo(gv.y)) * acc[m][0][2]; macc[m][0][3] += sigmoidf_(bfhi(gv.y)) * acc[m][0][3]; \
      macc[m][1][0] += sigmoidf_(bflo(gv.z)) * acc[m][1][0]; macc[m][1][1] += sigmoidf_(bfhi(gv.z)) * acc[m][1][1]; \
      macc[m][1][2] += sigmoidf_(bflo(gv.w)) * acc[m][1][2]; macc[m][1][3] += sigmoidf_(bfhi(gv.w)) * acc[m][1][3]; }
#pragma unroll 1
    for (int i = 0; i < 4; ++i) {
      f32x4 acc[4][2]; ACC_ZERO_N(acc, 2);
      const uint4 g0 = *(const uint4*)(gp + i * 1024), g1 = *(const uint4*)(gp + (size_t)16 * 4096 + i * 1024),
                  g2 = *(const uint4*)(gp + (size_t)32 * 4096 + i * 1024), g3 = *(const uint4*)(gp + (size_t)48 * 4096 + i * 1024);
      gemm_acc<0, 2, 4>(acc, YS + (size_t)m0 * 1024 + i * 256, 1024, WB + (size_t)n0 * 1024 + i * 256, 1024, smem);
      MROW(0, g0) MROW(1, g1) MROW(2, g2) MROW(3, g3)
    }
#undef MROW
    EPI_BEGIN_N(macc, 2)
      uint4 pk; pk.x = pk2(v0[0], v0[1]); pk.y = pk2(v0[2], v0[3]); pk.z = pk2(v1[0], v1[1]); pk.w = pk2(v1[2], v1[3]);
      *(uint4*)(MG + (size_t)(m0 + r) * 1024 + n0 + c) = pk;
    EPI_END
  }
}
__device__ __forceinline__ void phase_gemm_res(const Params& P, int l, int which, unsigned char* smem, bool dry, const TL& tl) {
  const bf16_t* A = (const bf16_t*)(PWS + (which == 0 ? OFF_U : OFF_M));
  const bf16_t* W = (const bf16_t*)(PWS + (which == 0 ? OFF_WO : OFF_W2));
  const int K = which == 0 ? 1024 : 4096;
  const float* mod = (const float*)(PWS + OFF_MOD);
  TILE_LOOP(16) {
    const int mt = TILE_MT, nt = TILE_NT, m0 = mt * 128, n0 = nt * 64;
    int start, L, ci; seq_of_tok(m0, start, L, ci);
    const float* gate = mod + (size_t)(l * 3 + ci) * 6144 + (which == 0 ? 2048 : 5120);
    f32x4 acc[4][2]; ACC_ZERO_N(acc, 2);
    #pragma unroll 1
    for (int kc = 0; kc < K; kc += 1024) gemm_acc<0, 2, 16>(acc, A + (size_t)m0 * K + kc, K, W + (size_t)n0 * K + kc, K, smem);
    EPI_BEGIN_N(acc, 2)
      float* xp = P.out + (size_t)(m0 + r) * 1024 + n0 + c;
      const f32x4 g0 = *(const f32x4*)(gate + n0 + c), g1 = *(const f32x4*)(gate + n0 + c + 4);
      f32x4 x0 = *(const f32x4*)xp, x1 = *(const f32x4*)(xp + 4);
      x0[0] += g0[0] * v0[0]; x0[1] += g0[1] * v0[1]; x0[2] += g0[2] * v0[2]; x0[3] += g0[3] * v0[3];
      x1[0] += g1[0] * v1[0]; x1[1] += g1[1] * v1[1]; x1[2] += g1[2] * v1[2]; x1[3] += g1[3] * v1[3];
      if (!dry) { *(f32x4*)xp = x0; *(f32x4*)(xp + 4) = x1; }
    EPI_END
  }
}
__device__ __forceinline__ void phase_mlp_up(const Params& P, unsigned char* smem, const TL& tl) {
  const bf16_t* H = (const bf16_t*)(PWS + OFF_H);
  const bf16_t* W1 = (const bf16_t*)(PWS + OFF_W1);
  bf16_t* HID = (bf16_t*)(PWS + OFF_M);
  TILE_LOOP(32) {
    const int mt = TILE_MT, nt = TILE_NT, m0 = mt * 128;
    f32x4 acc[4][4]; ACC_ZERO(acc);
    gemm_acc<0, 4, 16>(acc, H + (size_t)m0 * 1024, 1024, W1 + (size_t)nt * 128 * 1024, 1024, smem);
    EPI_BEGIN(acc)
      float o[8];
#pragma unroll
      for (int e = 0; e < 4; ++e) { const float a = fmaxf(v0[e], 0.f), b = fmaxf(v1[e], 0.f); o[e] = a * a; o[4 + e] = b * b; }
      uint4 pk; pk.x = pk2(o[0], o[1]); pk.y = pk2(o[2], o[3]); pk.z = pk2(o[4], o[5]); pk.w = pk2(o[6], o[7]);
      *(uint4*)(HID + (size_t)(m0 + r) * 4096 + nt * 128 + c) = pk;
    EPI_END
  }
}

__device__ __forceinline__ void pool_tile(const Params& P, int l, int tile, unsigned char* smem) {
  const int tid = otid(), tok0 = tile * 32;
  int start, L, ci; seq_of_tok(tok0, start, L, ci);
  const bf16_t* U = (const bf16_t*)(PWS + OFF_U);
  bf16_t* YS = (bf16_t*)(PWS + OFF_YS);
  float* pl = (float*)smem;
  bf16_t* zw = (bf16_t*)(smem + 32768);
  float* tw = (float*)(smem + 32768);
  float* ca = (float*)(smem + 49152);
  const int col = tid, g = col >> 6;
#pragma unroll
  for (int i = 0; i < 6; ++i) {
    const int c = tid + 256 * i;
    if (c < 47 * 32) {
      const int rr = c >> 5, cc = (c & 31) * 8, t = tok0 - 8 + rr - start;
      uint4 v = make_uint4(0u, 0u, 0u, 0u);
      if (t >= 0 && t < L) v = *(const uint4*)(U + (size_t)(start + t) * NU + UP + cc);
      *(uint4*)(zw + rr * 256 + cc) = v;
    }
  }
  __syncthreads();
  {
    const int half = 1 << g, win = 2 << g;
#pragma unroll 4
    for (int tt = 0; tt < 32; ++tt) {
      const int t = tok0 + tt - start;
      const int lo = max(t - half, 0), hi = min(t + half - 1, L - 1);
      float s = 0.f;
      const bf16_t* zp = zw + (tt + 8 - half) * 256 + col;
      for (int p = 0; p < win; ++p) s += bf2f(zp[p * 256]);
      pl[tt * 256 + col] = s / (float)(hi - lo + 1) - bf2f(zw[(tt + 8) * 256 + col]);
    }
  }
  __syncthreads();
  {
    float wreg[64];
    const float* pw = P.in[I_POOLW] + (size_t)(l * 4 + g) * 4096 + (col & 63);
#pragma unroll
    for (int cc = 0; cc < 64; ++cc) wreg[cc] = pw[cc * 64];
    const float ps = P.in[I_POOLS][l * 256 + col];
#pragma unroll 2
    for (int tt = 0; tt < 32; ++tt) {
      float a0 = 0.f, a1 = 0.f;
#pragma unroll
      for (int c4 = 0; c4 < 16; ++c4) {
        const f32x4 p4 = *(const f32x4*)(pl + tt * 256 + g * 64 + c4 * 4);
        a0 += p4[0] * wreg[c4 * 4] + p4[2] * wreg[c4 * 4 + 2];
        a1 += p4[1] * wreg[c4 * 4 + 1] + p4[3] * wreg[c4 * 4 + 3];
      }
      YS[(size_t)(tok0 + tt) * 1024 + col] = f2bf((a0 + a1) * ps);
    }
  }
  __syncthreads();
}
__device__ __forceinline__ void prep_tile(const Params& P, int l, int tile, unsigned char* smem) {
  const int tid = otid(), tok0 = tile * 32;
  int start, L, ci; seq_of_tok(tok0, start, L, ci);
  const bf16_t* U = (const bf16_t*)(PWS + OFF_U);
  bf16_t* YS = (bf16_t*)(PWS + OFF_YS);
  float* pl = (float*)smem;
  bf16_t* zw = (bf16_t*)(smem + 32768);
  float* tw = (float*)(smem + 32768);
  float* ca = (float*)(smem + 49152);
  const int col = tid, g = col >> 6;
#pragma unroll
  for (int i = 0; i < 3; ++i) {
    const int c = tid + 256 * i, tt = c / 24, j8 = (c % 24) * 8;
    const uint4 v = *(const uint4*)(U + (size_t)(tok0 + tt) * NU + UCW + j8);
    const unsigned w4[4] = {v.x, v.y, v.z, v.w};
#pragma unroll
    for (int e2 = 0; e2 < 4; ++e2) {
      const float x0 = bflo(w4[e2]), x1 = bfhi(w4[e2]);
      const int jj = j8 + 2 * e2;
      if (jj < 128) { tw[tt * 128 + jj] = 1.f - 2.f * __frcp_rn(1.f + __expf(2.f * x0)); tw[tt * 128 + jj + 1] = 1.f - 2.f * __frcp_rn(1.f + __expf(2.f * x1)); }
      else { ca[tt * 64 + jj - 128] = x0; ca[tt * 64 + jj - 127] = x1; }
    }
  }
  __syncthreads();
  float* Wd = (float*)(PWS + OFF_M + M_W);
  float aF[32], aB[32];
#pragma unroll 1
  for (int dir = 0; dir < 2; ++dir) {
    {
      float wreg[64];
      const float* bw = P.in[I_BW] + (size_t)(l * 2 + dir) * 64 * 256 + col;
#pragma unroll
      for (int r = 0; r < 64; ++r) wreg[r] = bw[r * 256];
      const float w0 = P.in[I_W0][(l * 2 + dir) * 256 + col];
#pragma unroll 2
      for (int tt = 0; tt < 32; ++tt) {
        float a0 = w0, a1 = 0.f;
#pragma unroll
        for (int r4 = 0; r4 < 16; ++r4) {
          const f32x4 x4 = *(const f32x4*)(tw + tt * 128 + dir * 64 + r4 * 4);
          a0 += x4[0] * wreg[r4 * 4] + x4[2] * wreg[r4 * 4 + 2];
          a1 += x4[1] * wreg[r4 * 4 + 1] + x4[3] * wreg[r4 * 4 + 3];
        }
        Wd[((size_t)dir * NT + tok0 + tt) * 256 + col] = __expf(-0.606531f * sigmoidf_(a0 + a1));
      }
    }
    {
      float wreg[32];
      const float* ba = P.in[I_BA] + (size_t)(l * 2 + dir) * 32 * 256 + col;
#pragma unroll
      for (int r = 0; r < 32; ++r) wreg[r] = ba[r * 256];
      const float a0c = P.in[I_A0][(l * 2 + dir) * 256 + col];
#pragma unroll
      for (int tt = 0; tt < 32; ++tt) {
        float a0 = a0c, a1 = 0.f;
#pragma unroll
        for (int r4 = 0; r4 < 8; ++r4) {
          const f32x4 x4 = *(const f32x4*)(ca + tt * 64 + dir * 32 + r4 * 4);
          a0 += x4[0] * wreg[r4 * 4] + x4[2] * wreg[r4 * 4 + 2];
          a1 += x4[1] * wreg[r4 * 4 + 1] + x4[3] * wreg[r4 * 4 + 3];
        }
        const float a = sigmoidf_(a0 + a1);
        if (dir == 0) aF[tt] = a; else aB[tt] = a;
      }
    }
  }
  {
    bf16_t* Rr = (bf16_t*)(PWS + OFF_M + M_R);
    bf16_t* Vv = (bf16_t*)(PWS + OFF_M + M_V);
    bf16_t* KKn = (bf16_t*)(PWS + OFF_M + M_KK);
    bf16_t* KD = (bf16_t*)(PWS + OFF_M + M_KD);
    bf16_t* Bb = (bf16_t*)(PWS + OFF_M + M_B);
    float* ORW = (float*)(PWS + OFF_ORW);
    const float mur = P.in[I_MU][l * 768 + col], muk = P.in[I_MU][l * 768 + 256 + col], muv = P.in[I_MU][l * 768 + 512 + col];
    const float kkp = P.in[I_KKP][l * 256 + col], ka = P.in[I_KA][l * 256 + col];
#pragma unroll
    for (int tt = 0; tt < 32; ++tt) {
      const int tok = tok0 + tt, t = tok - start;
      const bf16_t* u0 = U + (size_t)tok * NU;
      const float zr = bf2f(u0[UR + col]), zk = bf2f(u0[UK + col]), zv = bf2f(u0[UV + col]);
      float pr = 0.f, pk = 0.f, pv = 0.f, nr = 0.f, nk = 0.f, nv = 0.f;
      if (t > 0) { pr = bf2f(u0[UR + col - NU]); pk = bf2f(u0[UK + col - NU]); pv = bf2f(u0[UV + col - NU]); }
      if (t < L - 1) { nr = bf2f(u0[UR + col + NU]); nk = bf2f(u0[UK + col + NU]); nv = bf2f(u0[UV + col + NU]); }
      const float r = zr + mur * (0.5f * (pr + nr) - zr);
      const float k = zk + muk * (0.5f * (pk + nk) - zk);
      const float v = zv + muv * (0.5f * (pv + nv) - zv);
      float kk = k * kkp;
      const float ss = wave_sum(kk * kk);
      kk *= rsqrtf(ss + 1e-6f);
      const size_t o = (size_t)tok * 256 + col;
      Rr[o] = f2bf(r); Vv[o] = f2bf(v); KKn[o] = f2bf(kk);
      KD[o] = f2bf(k * (1.f + (aF[tt] - 1.f) * ka)); KD[(size_t)NT * 256 + o] = f2bf(k * (1.f + (aB[tt] - 1.f) * ka));
      Bb[o] = f2bf(kk * aF[tt]); Bb[(size_t)NT * 256 + o] = f2bf(kk * aB[tt]);
      ORW[o] = 0.f;
    }
  }
  __syncthreads();
}

__device__ __forceinline__ void gla_bcum(const Params& P, int l, int dir, int h, int c0, float* gs) {
  const int tid = otid();
  const bf16_t* U = (const bf16_t*)(PWS + OFF_U);
  {
    const int pp = tid >> 2, dq = tid & 3, tok = dir ? c0 + 63 - pp : c0 + pp;
    const uint4* cp = (const uint4*)(U + (size_t)tok * NU + UCAL + dir * 16);
    const uint4 c0v = cp[0], c1v = cp[1];
    float cal[16];
    cal[0] = bflo(c0v.x); cal[1] = bfhi(c0v.x); cal[2] = bflo(c0v.y); cal[3] = bfhi(c0v.y); cal[4] = bflo(c0v.z); cal[5] = bfhi(c0v.z); cal[6] = bflo(c0v.w); cal[7] = bfhi(c0v.w);
    cal[8] = bflo(c1v.x); cal[9] = bfhi(c1v.x); cal[10] = bflo(c1v.y); cal[11] = bfhi(c1v.y); cal[12] = bflo(c1v.z); cal[13] = bfhi(c1v.z); cal[14] = bflo(c1v.w); cal[15] = bfhi(c1v.w);
    const float* ab = P.in[I_GAB] + (size_t)(l * 2 + dir) * 16 * 128 + h * 32 + dq * 8;
    const float* bias = P.in[I_GABIAS] + (l * 2 + dir) * 128 + h * 32 + dq * 8;
#pragma unroll
    for (int dd = 0; dd < 8; ++dd) {
      float x = bias[dd];
#pragma unroll
      for (int r = 0; r < 16; ++r) x += cal[r] * ab[r * 128 + dd];
      const float ls = fminf(x, 0.f) - __logf(1.f + __expf(-fabsf(x)));
      gs[pp * 32 + dq * 8 + dd] = ls * (1.f / 16.f);
    }
  }
  __syncthreads();
  {
    float* segs = gs + 10240;
    const int d = tid & 31, sg_ = tid >> 5;
    float v[8], run = 0.f;
#pragma unroll
    for (int i = 0; i < 8; ++i) { run += gs[(sg_ * 8 + i) * 32 + d]; v[i] = run; }
    segs[sg_ * 32 + d] = run;
    __syncthreads();
    float off = 0.f;
#pragma unroll
    for (int s2 = 0; s2 < 7; ++s2) off += (s2 < sg_) ? segs[s2 * 32 + d] : 0.f;
#pragma unroll
    for (int i = 0; i < 8; ++i) gs[(sg_ * 8 + i) * 32 + d] = v[i] + off;
  }
  __syncthreads();
}
__device__ __forceinline__ void gla_g1(const Params& P, int l, int item, unsigned char* smem) {
  const int tid = otid();
  const int dir = item & 1, h = (item >> 1) & 3, cgi = item >> 3, c0 = cgi * 64;
  const bf16_t* U = (const bf16_t*)(PWS + OFF_U);
  float* gs = (float*)smem;
  float* kt = (float*)(smem + 8192);
  float* vs = (float*)(smem + 16384);
  gla_bcum(P, l, dir, h, c0, gs);
  {
    const int pp = tid >> 2, q4 = tid & 3, tok = dir ? c0 + 63 - pp : c0 + pp;
    const uint4 kv = *(const uint4*)(U + (size_t)tok * NU + UGK + h * 32 + q4 * 8);
    const unsigned kw[4] = {kv.x, kv.y, kv.z, kv.w};
#pragma unroll
    for (int i = 0; i < 4; ++i) {
      const int d = q4 * 8 + 2 * i;
      kt[pp * 32 + d] = bflo(kw[i]) * __expf(gs[63 * 32 + d] - gs[pp * 32 + d]);
      kt[pp * 32 + d + 1] = bfhi(kw[i]) * __expf(gs[63 * 32 + d + 1] - gs[pp * 32 + d + 1]);
    }
    const uint4* vp = (const uint4*)(U + (size_t)tok * NU + UGV + h * 64 + q4 * 16);
    const uint4 v0 = vp[0], v1 = vp[1];
    const unsigned vw[8] = {v0.x, v0.y, v0.z, v0.w, v1.x, v1.y, v1.z, v1.w};
#pragma unroll
    for (int i = 0; i < 8; ++i) { vs[pp * 64 + q4 * 16 + 2 * i] = bflo(vw[i]); vs[pp * 64 + q4 * 16 + 2 * i + 1] = bfhi(vw[i]); }
  }
  __syncthreads();
  {
    const int e = tid & 63, dq = tid >> 6;
    float acc[8];
#pragma unroll
    for (int dd = 0; dd < 8; ++dd) acc[dd] = 0.f;
    for (int pp = 0; pp < 64; ++pp) {
      const float vv = vs[pp * 64 + e];
#pragma unroll
      for (int dd = 0; dd < 8; ++dd) acc[dd] += kt[pp * 32 + dq * 8 + dd] * vv;
    }
    float* S = (float*)(PWS + OFF_M + M_GS) + (size_t)item * 2080;
#pragma unroll
    for (int dd = 0; dd < 8; ++dd) S[(dq * 8 + dd) * 64 + e] = acc[dd];
    if (tid < 32) S[2048 + tid] = __expf(gs[63 * 32 + tid]);
  }
  __syncthreads();
}
__device__ __forceinline__ void gla_g2(const Params& P, int l, int item, unsigned char* smem) {
  const int tid = otid();
  const int h = item & 3, cgi = item >> 2, c0 = cgi * 64;
  int start, L, ci; seq_of_tok(c0, start, L, ci);
  const int cfirst = start >> 6, nc = L >> 6;
  const bf16_t* U = (const bf16_t*)(PWS + OFF_U);
  const float* GS = (const float*)(PWS + OFF_M + M_GS);
  float* gs = (float*)smem;
  float* qt = (float*)(smem + 8192);
  float* kt = (float*)(smem + 16384);
  float* vs = (float*)(smem + 24576);
  float* att = (float*)(smem + 40960);
  float* Sp = (float*)(smem + 57600);
  const int e = tid & 63, pq = tid >> 6;
  float oacc[16];
#pragma unroll
  for (int i = 0; i < 16; ++i) oacc[i] = 0.f;
#pragma unroll 1
  for (int dir = 0; dir < 2; ++dir) {
    gla_bcum(P, l, dir, h, c0, gs);
    {
      float S[8];
      if (ci == 0) {
#pragma unroll
        for (int dd = 0; dd < 8; ++dd) S[dd] = 0.f;
      } else {
        const float* s0 = P.in[I_SGL] + ((((size_t)(ci - 1) * 2 + l) * 2 + dir) * 4 + h) * 2048;
#pragma unroll
        for (int dd = 0; dd < 8; ++dd) S[dd] = s0[(pq * 8 + dd) * 64 + e];
      }
      if (dir == 0) {
        for (int j = cfirst; j < cgi; ++j) {
          const float* sj = GS + (size_t)((j * 4 + h) * 2 + 0) * 2080;
#pragma unroll
          for (int dd = 0; dd < 8; ++dd) S[dd] = sj[2048 + pq * 8 + dd] * S[dd] + sj[(pq * 8 + dd) * 64 + e];
        }
      } else {
        for (int j = cfirst + nc - 1; j > cgi; --j) {
          const float* sj = GS + (size_t)((j * 4 + h) * 2 + 1) * 2080;
#pragma unroll
          for (int dd = 0; dd < 8; ++dd) S[dd] = sj[2048 + pq * 8 + dd] * S[dd] + sj[(pq * 8 + dd) * 64 + e];
        }
      }
#pragma unroll
      for (int dd = 0; dd < 8; ++dd) Sp[(pq * 8 + dd) * 64 + e] = S[dd];
      const bool last = dir == 0 ? (cgi == cfirst + nc - 1) : (cgi == cfirst);
      if (ci == 0 && last) {
        const float* sj = GS + (size_t)((cgi * 4 + h) * 2 + dir) * 2080;
        const int b = start >> 8;
        float* dst = P.out + OUT_SG + ((((size_t)b * 2 + l) * 2 + dir) * 4 + h) * 2048;
#pragma unroll
        for (int dd = 0; dd < 8; ++dd) dst[(pq * 8 + dd) * 64 + e] = sj[2048 + pq * 8 + dd] * S[dd] + sj[(pq * 8 + dd) * 64 + e];
      }
    }
    {
      const int pp = tid >> 2, q4 = tid & 3, tok = dir ? c0 + 63 - pp : c0 + pp;
      const uint4 qv = *(const uint4*)(U + (size_t)tok * NU + UGQ + h * 32 + q4 * 8);
      const uint4 kv = *(const uint4*)(U + (size_t)tok * NU + UGK + h * 32 + q4 * 8);
      const unsigned qw[4] = {qv.x, qv.y, qv.z, qv.w};
      const unsigned kw[4] = {kv.x, kv.y, kv.z, kv.w};
#pragma unroll
      for (int i = 0; i < 4; ++i) {
        const int d = q4 * 8 + 2 * i;
        const float b0 = gs[pp * 32 + d], b1 = gs[pp * 32 + d + 1];
        qt[pp * 32 + d] = bflo(qw[i]) * 0.17677669529663687f * __expf(b0);
        qt[pp * 32 + d + 1] = bfhi(qw[i]) * 0.17677669529663687f * __expf(b1);
        kt[pp * 32 + d] = bflo(kw[i]) * __expf(-b0);
        kt[pp * 32 + d + 1] = bfhi(kw[i]) * __expf(-b1);
      }
      const uint4* vp = (const uint4*)(U + (size_t)tok * NU + UGV + h * 64 + q4 * 16);
      const uint4 v0 = vp[0], v1 = vp[1];
      const unsigned vw[8] = {v0.x, v0.y, v0.z, v0.w, v1.x, v1.y, v1.z, v1.w};
#pragma unroll
      for (int i = 0; i < 8; ++i) { vs[pp * 64 + q4 * 16 + 2 * i] = bflo(vw[i]); vs[pp * 64 + q4 * 16 + 2 * i + 1] = bfhi(vw[i]); }
    }
    __syncthreads();
    {
      const int pp = tid >> 2, sq = tid & 3;
      float qr[32];
#pragma unroll
      for (int d = 0; d < 32; ++d) qr[d] = qt[pp * 32 + d];
#pragma unroll 1
      for (int si = 0; si < 16; ++si) {
        const int s = sq * 16 + si;
        float a = 0.f;
        if (s <= pp) {
#pragma unroll
          for (int d = 0; d < 32; ++d) a += qr[d] * kt[s * 32 + d];
        }
        att[pp * 65 + s] = a;
      }
    }
    __syncthreads();
    {
#pragma unroll 2
      for (int s = 0; s < 64; ++s) {
        const float vv = vs[s * 64 + e];
#pragma unroll
        for (int i = 0; i < 16; ++i) { const int tau = pq * 16 + i, pp = dir ? 63 - tau : tau; oacc[i] += att[pp * 65 + s] * vv; }
      }
#pragma unroll 2
      for (int d = 0; d < 32; ++d) {
        const float sv = Sp[d * 64 + e];
#pragma unroll
        for (int i = 0; i < 16; ++i) { const int tau = pq * 16 + i, pp = dir ? 63 - tau : tau; oacc[i] += qt[pp * 32 + d] * sv; }
      }
    }
    __syncthreads();
  }
  {
    bf16_t* YS = (bf16_t*)(PWS + OFF_YS);
    const float gnorm = P.in[I_GNORM][l * 256 + h * 64 + e];
#pragma unroll
    for (int i = 0; i < 16; ++i) {
      const size_t tok = (size_t)(c0 + pq * 16 + i);
      const float og = oacc[i];
      const float ms = wave_sum(og * og) * (1.f / 64.f);
      const float go = bf2f(U[tok * NU + UGO + h * 64 + e]);
      YS[tok * 1024 + 768 + h * 64 + e] = f2bf(og * rsqrtf(ms + 1e-6f) * gnorm * (go * sigmoidf_(go)));
    }
  }
}

#define SC_BUF 22528
__device__ __forceinline__ void rwkv_scan(const Params& P, int l, int item, bool dry, unsigned char* smem) {
  const int tid = otid();
  int seq, sub;
  if (item < 64) { seq = 16 + (item >> 5); sub = item & 31; } else { seq = (item - 64) >> 5; sub = (item - 64) & 31; }
  const int h = sub >> 3, dir = (sub >> 2) & 1, rg = sub & 3;
  const int start = seq < 16 ? seq * 256 : 4096 + (seq - 16) * 4096, L = seq < 16 ? 256 : 4096;
  const int rowl = tid >> 4, j = tid & 15, row = rg * 16 + rowl;
  unsigned char* ws = PWS;
  const float* Wd = (const float*)(ws + OFF_M + M_W) + (size_t)dir * NT * 256 + h * 64 + j * 4;
  const bf16_t* KD = (const bf16_t*)(ws + OFF_M + M_KD) + (size_t)dir * NT * 256 + h * 64 + j * 4;
  const bf16_t* Bb = (const bf16_t*)(ws + OFF_M + M_B) + (size_t)dir * NT * 256 + h * 64 + j * 4;
  const bf16_t* Rr = (const bf16_t*)(ws + OFF_M + M_R) + h * 64 + j * 4;
  const bf16_t* KKn = (const bf16_t*)(ws + OFF_M + M_KK) + h * 64 + j * 4;
  const bf16_t* Vv = (const bf16_t*)(ws + OFF_M + M_V) + h * 64 + rg * 16 + j;
  float* ORW = (float*)(ws + OFF_ORW) + h * 64 + rg * 16 + j;
  typedef float f32x2 __attribute__((ext_vector_type(2)));
  f32x2 S01, S23;
  if (seq < 16) {
    S01 = (f32x2){0.f, 0.f}; S23 = (f32x2){0.f, 0.f};
  } else {
    const f32x4 s0 = *(const f32x4*)(P.in[I_SRW] + (((((size_t)(seq - 16) * 2 + l) * 2 + dir) * 4 + h) * 64 + row) * 64 + j * 4);
    S01 = (f32x2){s0[0], s0[1]}; S23 = (f32x2){s0[2], s0[3]};
  }
  f32x4 gw; uint2 gkd, gb, gkk, gr; unsigned gv;
  const int nch = L >> 4;
#define SC_TOK(c_) ((size_t)(start + (dir ? L - 1 - ((c_) * 16 + rowl) : (c_) * 16 + rowl)))
#define SC_LOAD(c_) { const size_t tk = SC_TOK(c_) * 256; gw = *(const f32x4*)(Wd + tk); gkd = *(const uint2*)(KD + tk); gb = *(const uint2*)(Bb + tk); \
    gkk = *(const uint2*)(KKn + tk); gr = *(const uint2*)(Rr + tk); gv = Vv[tk]; }
#define SC_STORE(b_) { float* base = (float*)(smem + (b_) * SC_BUF) + rowl * 64 + j * 4; \
    *(f32x4*)(base) = gw; \
    *(f32x4*)(base + 1024) = (f32x4){bflo(gkd.x), bfhi(gkd.x), bflo(gkd.y), bfhi(gkd.y)}; \
    *(f32x4*)(base + 2048) = (f32x4){bflo(gb.x), bfhi(gb.x), bflo(gb.y), bfhi(gb.y)}; \
    *(f32x4*)(base + 3072) = (f32x4){bflo(gkk.x), bfhi(gkk.x), bflo(gkk.y), bfhi(gkk.y)}; \
    *(f32x4*)(base + 4096) = (f32x4){bflo(gr.x), bfhi(gr.x), bflo(gr.y), bfhi(gr.y)}; \
    ((float*)(smem + (b_) * SC_BUF + 20480))[j * 16 + rowl] = __uint_as_float(gv << 16); }
  SC_LOAD(0)
  SC_STORE(0)
  if (nch > 1) SC_LOAD(1)
  __syncthreads();
#pragma unroll 1
  for (int c = 0; c < nch; ++c) {
    const float* buf = (const float*)(smem + (c & 1) * SC_BUF);
    float* outl = (float*)(smem + (c & 1) * SC_BUF + 21504);
    float myout = 0.f;
    f32x4 v4[4];
#pragma unroll
    for (int i = 0; i < 4; ++i) v4[i] = *(const f32x4*)(buf + 5120 + rowl * 16 + i * 4);
    f32x4 w4 = *(const f32x4*)(buf + j * 4), kd4 = *(const f32x4*)(buf + 1024 + j * 4), b4 = *(const f32x4*)(buf + 2048 + j * 4),
          kk4 = *(const f32x4*)(buf + 3072 + j * 4), r4 = *(const f32x4*)(buf + 4096 + j * 4);
    float dot;
    {
      f32x2 p = S01 * (f32x2){kk4[0], kk4[1]};
      p = S23 * (f32x2){kk4[2], kk4[3]} + p;
      dot = row16_sum(p[0] + p[1]);
    }
#pragma unroll
    for (int s = 0; s < 16; ++s) {
      f32x4 w4n, kd4n, b4n, kk4n, r4n;
      if (s < 15) {
        w4n = *(const f32x4*)(buf + (s + 1) * 64 + j * 4);
        kd4n = *(const f32x4*)(buf + 1024 + (s + 1) * 64 + j * 4);
        b4n = *(const f32x4*)(buf + 2048 + (s + 1) * 64 + j * 4);
        kk4n = *(const f32x4*)(buf + 3072 + (s + 1) * 64 + j * 4);
        r4n = *(const f32x4*)(buf + 4096 + (s + 1) * 64 + j * 4);
      }
      __builtin_amdgcn_sched_barrier(0);
      const float vf = v4[s >> 2][s & 3];
      const f32x2 t01 = S01 * (f32x2){w4[0], w4[1]} + (f32x2){kd4[0], kd4[1]} * vf;
      const f32x2 t23 = S23 * (f32x2){w4[2], w4[3]} + (f32x2){kd4[2], kd4[3]} * vf;
      S01 = t01 - (f32x2){b4[0], b4[1]} * dot;
      S23 = t23 - (f32x2){b4[2], b4[3]} * dot;
      f32x2 o = S01 * (f32x2){r4[0], r4[1]};
      o = S23 * (f32x2){r4[2], r4[3]} + o;
      float od = o[0] + o[1];
      if (s < 15) {
        f32x2 p = S01 * (f32x2){kk4n[0], kk4n[1]};
        p = S23 * (f32x2){kk4n[2], kk4n[3]} + p;
        float dn = p[0] + p[1];
        row16_sum2(dn, od);
        dot = dn;
        w4 = w4n; kd4 = kd4n; b4 = b4n; kk4 = kk4n; r4 = r4n;
      } else {
        od = row16_sum(od);
      }
      myout = (j == s) ? od : myout;
    }
    outl[j * 16 + rowl] = myout;
    if (c + 1 < nch) SC_STORE((c + 1) & 1)
    __syncthreads();
    if (!dry) __hip_atomic_fetch_add(ORW + SC_TOK(c) * 256, outl[rowl * 16 + j], __ATOMIC_RELAXED, __HIP_MEMORY_SCOPE_AGENT);
    if (c + 2 < nch) SC_LOAD(c + 2)
  }
#undef SC_TOK
#undef SC_LOAD
#undef SC_STORE
  if (seq < 16 && !dry) {
    f32x4 o; o[0] = S01[0]; o[1] = S01[1]; o[2] = S23[0]; o[3] = S23[1];
    *(f32x4*)(P.out + OUT_SR + (((((size_t)seq * 2 + l) * 2 + dir) * 4 + h) * 64 + row) * 64 + j * 4) = o;
  }
  __syncthreads();
}

__device__ __forceinline__ void fourier_tile(const Params& P, int item, unsigned char* smem) {
  int seq, mt, nt;
  if (item < 128) { seq = 16 + (item >> 6); mt = (item >> 1) & 31; nt = item & 1; }
  else { const int r = item - 128; seq = r >> 2; mt = (r >> 1) & 1; nt = r & 1; }
  const int start = seq < 16 ? seq * 256 : 4096 + (seq - 16) * 4096, L = seq < 16 ? 256 : 4096, sh = seq < 16 ? 4 : 0;
  const bf16_t* ZT = (const bf16_t*)(PWS + OFF_ZT);
  bf16_t* YS = (bf16_t*)(PWS + OFF_YS);
  f32x4 acc[4][4]; ACC_ZERO(acc);
  if (seq < 16) {
    gemm_acc<1, 4, 4>(acc, nullptr, 0, ZT + (size_t)(nt * 128) * NT + start, NT, smem, mt * 128, 255, 4, 0, 0);
    gemm_acc<1, 4, 4>(acc, nullptr, 0, ZT + (size_t)(256 + nt * 128) * NT + start, NT, smem, mt * 128, 255, 4, 3072, 0);
  } else {
#pragma unroll 1
    for (int pass = 0; pass < 8; ++pass) {
      const int nb = (pass & 3) * 1024, sn = pass >> 2;
      gemm_acc<1, 4, 16>(acc, nullptr, 0, ZT + (size_t)(sn * 256 + nt * 128) * NT + start + nb, NT, smem, mt * 128, 4095, 0, sn ? 3072 : 0, nb);
    }
  }
  const float scl = seq < 16 ? 0.0625f : 0.015625f;
  EPI_BEGIN(acc)
    uint4 pk; pk.x = pk2(v0[0] * scl, v0[1] * scl); pk.y = pk2(v0[2] * scl, v0[3] * scl); pk.z = pk2(v1[0] * scl, v1[1] * scl); pk.w = pk2(v1[2] * scl, v1[3] * scl);
    *(uint4*)(YS + (size_t)(start + mt * 128 + r) * 1024 + 256 + nt * 128 + c) = pk;
  EPI_END
}

#define CT 24
__device__ __forceinline__ void gatec_tile(const Params& P, int l, int tile, unsigned char* smem) {
  const int tid = otid(), tok0 = tile * CT, col = tid;
  const bf16_t* U = (const bf16_t*)(PWS + OFF_U);
  bf16_t* YS = (bf16_t*)(PWS + OFF_YS);
  float* sg = (float*)smem;
  for (int i = tid; i < CT * 64; i += 256) sg[i] = sigmoidf_(bf2f(U[(size_t)(tok0 + (i >> 6)) * NU + UCG + (i & 63)]));
  __syncthreads();
  float gate[CT];
  {
    float wreg[64];
    const float* bg = P.in[I_BG] + (size_t)l * 64 * 256 + col;
#pragma unroll
    for (int r = 0; r < 64; ++r) wreg[r] = bg[r * 256];
#pragma unroll
    for (int tt = 0; tt < CT; ++tt) {
      float a0 = 0.f, a1 = 0.f;
#pragma unroll
      for (int r4 = 0; r4 < 16; ++r4) {
        const f32x4 x4 = *(const f32x4*)(sg + tt * 64 + r4 * 4);
        a0 += x4[0] * wreg[r4 * 4] + x4[2] * wreg[r4 * 4 + 2];
        a1 += x4[1] * wreg[r4 * 4 + 1] + x4[3] * wreg[r4 * 4 + 3];
      }
      gate[tt] = a0 + a1;
    }
  }
  float* GC = (float*)(PWS + OFF_M + M_OG);
#pragma unroll
  for (int tt = 0; tt < CT; ++tt) GC[(size_t)(tok0 + tt) * 256 + col] = gate[tt];
  __syncthreads();
}
__device__ __forceinline__ void combine_tile(const Params& P, int l, int tile, unsigned char* smem) {
  const int tid = otid(), tok0 = tile * CT, col = tid;
  bf16_t* YS = (bf16_t*)(PWS + OFF_YS);
  const float* GC = (const float*)(PWS + OFF_M + M_OG);
  const bf16_t* Rr = (const bf16_t*)(PWS + OFF_M + M_R);
  const bf16_t* Vv = (const bf16_t*)(PWS + OFF_M + M_V);
  const bf16_t* KD = (const bf16_t*)(PWS + OFF_M + M_KD);
  const float* ORW = (const float*)(PWS + OFF_ORW);
  const float gn = P.in[I_GN][l * 256 + col], rk = P.in[I_RK][l * 256 + col];
#pragma unroll
  for (int tt = 0; tt < CT; ++tt) {
    const size_t o = (size_t)(tok0 + tt) * 256 + col;
    const float ov = ORW[o];
    const float mu = wave_sum(ov) * (1.f / 64.f);
    const float dv = ov - mu;
    const float var = wave_sum(dv * dv) * (1.f / 64.f);
    const float on = dv * rsqrtf(var + 64e-5f) * gn;
    const float r = bf2f(Rr[o]), v = bf2f(Vv[o]);
    const float kds = bf2f(KD[o]) + bf2f(KD[(size_t)NT * 256 + o]);
    const float bonus = wave_sum(r * kds * rk);
    const float yc = (on + bonus * v) * GC[o];
    YS[(size_t)(tok0 + tt) * 1024 + 512 + col] = f2bf(yc);
  }
  __syncthreads();
}


#define OFF_BAR WS_END
#define XB_TMO      128
#define XB_XCNT(j)  (256  + 64 * (j))
#define XB_XSUB(j)  (1280 + 64 * (j))
#define XB_XGEN(j)  (2304 + 64 * (j))
#define XB_TOP      3328
#define XB_TOPGEN   3392
#define XCD_BAR_WORDS 3456
#define XB_SPIN_CAP (1u << 18)
#define LAS __attribute__((address_space(3)))

__device__ __forceinline__ unsigned xb_ld(unsigned* p)              { return __hip_atomic_load(p, __ATOMIC_RELAXED, __HIP_MEMORY_SCOPE_AGENT); }
__device__ __forceinline__ unsigned xb_add(unsigned* p, unsigned v) { return __hip_atomic_fetch_add(p, v, __ATOMIC_RELAXED, __HIP_MEMORY_SCOPE_AGENT); }
__device__ __forceinline__ unsigned xb_xcc_id() { return (unsigned)__builtin_amdgcn_s_getreg((3 << 11) | 20) & 0xFu; }
#define XB_SPIN(cond, bar) do { unsigned _sp = 0; while (cond) { __builtin_amdgcn_s_sleep(1); \
    if ((++_sp & 255u) == 0u) { if (xb_ld(&(bar)[XB_TMO])) break; if (_sp > XB_SPIN_CAP) { atomicAdd(&(bar)[XB_TMO], 1u); break; } } } } while (0)

struct XcdBarrier {
    unsigned* bar; unsigned x;
    volatile LAS unsigned* st;
};

__device__ __forceinline__ XcdBarrier xcd_barrier_post(unsigned* bar, volatile LAS unsigned* st) {
    XcdBarrier b; b.bar = bar; b.x = xb_xcc_id(); b.st = st;
    if (otid() == 0) st[2] = xb_add(&bar[XB_XCNT(b.x)], 1u);
    return b;
}
__device__ __forceinline__ void xcd_barrier_complete(unsigned* bar, unsigned x, unsigned& nloc, unsigned& nx) {
    const unsigned G = gridDim.x * gridDim.y * gridDim.z;
    unsigned sum, cnt, mine, sp = 0u;
    for (;;) {
        sum = 0u; cnt = 0u; mine = 0u;
#pragma unroll
        for (unsigned j = 0; j < 16; ++j) { const unsigned c = xb_ld(&bar[XB_XCNT(j)]); sum += c; cnt += (c > 0u) ? 1u : 0u; mine = (j == x) ? c : mine; }
        if (sum == G) break;
        __builtin_amdgcn_s_sleep(1);
        if ((++sp & 255u) == 0u) { if (xb_ld(&bar[XB_TMO])) break; if (sp > XB_SPIN_CAP) { atomicAdd(&bar[XB_TMO], 1u); break; } }
    }
    nloc = mine > 0u ? mine : 1u; nx = cnt > 0u ? cnt : 1u;
}

__device__ __forceinline__ void xcd_barrier(const XcdBarrier& b) {
    asm volatile("s_waitcnt vmcnt(0)" ::: "memory");
    __syncthreads();
    if (otid() == 0) {
        unsigned* bar = b.bar;
        __builtin_amdgcn_s_waitcnt(0);
        unsigned nloc = b.st[0], nx = b.st[1];
        if (nloc == 0u) { xcd_barrier_complete(bar, b.x, nloc, nx); b.st[0] = nloc; b.st[1] = nx; }
        const unsigned old = xb_add(&bar[XB_XSUB(b.x)], 1u);
        const unsigned gen = old / nloc;
        if (old + 1u == (gen + 1u) * nloc) {
            __builtin_amdgcn_fence(__ATOMIC_RELEASE, "agent");
            asm volatile("s_waitcnt vmcnt(0)" ::: "memory");
            const unsigned og = xb_add(&bar[XB_TOP], 1u);
            const unsigned tg = og / nx;
            if (og + 1u == (tg + 1u) * nx) xb_add(&bar[XB_TOPGEN], 1u);
            else XB_SPIN(xb_ld(&bar[XB_TOPGEN]) == tg, bar);
            __builtin_amdgcn_fence(__ATOMIC_ACQUIRE, "agent");
            xb_add(&bar[XB_XGEN(b.x)], 1u);
            asm volatile("s_waitcnt vmcnt(0)" ::: "memory");
        } else {
            XB_SPIN(xb_ld(&bar[XB_XGEN(b.x)]) == gen, bar);
            __builtin_amdgcn_fence(__ATOMIC_ACQUIRE, "agent");
            asm volatile("s_waitcnt vmcnt(0)" ::: "memory");
        }
    }
    __syncthreads();
}
#define gsync(P_, e_) xcd_barrier(xb)

#ifndef R_P0
#define R_P0 1
#endif
#ifndef R_NORM
#define R_NORM 1
#endif
#ifndef R_GEMM
#define R_GEMM 1
#endif
#ifndef R_PREP
#define R_PREP 1
#endif
#ifndef R_SCAN
#define R_SCAN 1
#endif
#ifndef R_FOUR
#define R_FOUR 1
#endif
#ifndef R_G2
#define R_G2 1
#endif
#define REP(n) for (int rep = 0; rep < 1; ++rep)
__global__ void __launch_bounds__(256, 2) mega(Params P) {
  extern __shared__ __attribute__((aligned(16))) unsigned char smem[];
  cg::grid_group grid = cg::this_grid();
  const int G = gridDim.x;
  unsigned epoch = 0;
  int zero = 0; asm volatile("" : "+s"(zero));
  volatile LAS unsigned* xst = (volatile LAS unsigned*)(LAS unsigned char*)(smem + LDS_BYTES - 16);
  if (otid() == 0) { xst[0] = 0u; xst[1] = 0u; }
  __syncthreads();
  XcdBarrier xb = xcd_barrier_post((unsigned*)(PWS + OFF_BAR), xst);
  grid.sync();
  REP(R_P0) {
    phase_mod(P, smem);
    __syncthreads();
    phase_table(P);
    {
      const int nb = G > 256 ? G - 192 : G;
      if (G > 256) { if ((int)blockIdx.x >= 192) phase_convert(P, 0, smem, blockIdx.x - 192, nb); }
      else phase_convert(P, 0, smem, blockIdx.x, nb);
    }
  }
  gsync(P, epoch);
  TL tl;
  {
    const unsigned nloc = xst[0], nx = xst[1], jl = xst[2];
    if (nx == 8u && xb.x < 8u && nloc > 0u) { tl.x = (int)xb.x; tl.j = (int)jl; tl.n = (int)nloc; }
    else { tl.x = blockIdx.x & 7; tl.j = blockIdx.x >> 3; tl.n = G >> 3; }
  }
#pragma unroll 1
  for (int l = 0; l < 2; ++l) {
    REP(R_NORM) {
      if (l == 1) phase_convert(P, 1, smem, blockIdx.x, G);
      phase_norm(P, l, 0);
    }
    gsync(P, epoch);
    REP(R_GEMM) phase_gemm1(P, smem, tl);
#ifdef DUP_GEMM
    phase_gemm1(P, smem, tl);
#endif
    gsync(P, epoch);
    if (G > 384 + 64) {
      if ((int)blockIdx.x < 384) prep_tile(P, l, blockIdx.x, smem);
      else for (int it = blockIdx.x - 384; it < 1536; it += G - 384) gla_g1(P, l, it, smem);
    } else {
      for (int it = blockIdx.x; it < 384 + 1536; it += G) {
        if (it < 384) prep_tile(P, l, it, smem); else gla_g1(P, l, it - 384, smem);
      }
    }
#ifdef DUP_PREP
    for (int it = blockIdx.x; it < 384; it += G) prep_tile(P, l, it, smem);
#endif
#ifdef DUP_G1
    for (int it = blockIdx.x + 384; it < 384 + 1536; it += G) gla_g1(P, l, it - 384, smem);
#endif
    gsync(P, epoch);
    {
      const bf16_t* tabg = (const bf16_t*)(PWS + OFF_TAB);
      bf16_t* tabl = (bf16_t*)(smem + LDS_TAB);
      for (int i = otid(); i < 4096; i += 256) tabl[i] = tabg[i];
      __syncthreads();
      if (G >= 256) {
        const int b = blockIdx.x;
        const bool is_scan = b < 128 && (b & 8) == 0;
        if (is_scan) rwkv_scan(P, l, (b >> 4) * 8 + (b & 7), false, smem);
        else {
          const int ob = b < 128 ? (b >> 4) * 8 + (b & 7) : b - 64;
          for (int it = 64 + ob; it < 576 + 192 + 768 + 384 + NT / CT; it += G - 64) {
            if (it < 576) rwkv_scan(P, l, it, false, smem);
            else if (it < 768) fourier_tile(P, it - 576, smem);
            else if (it < 1536) gla_g2(P, l, it - 768, smem);
            else if (it < 1920) pool_tile(P, l, it - 1536, smem);
            else gatec_tile(P, l, it - 1920, smem);
          }
        }
      } else {
        for (int it = blockIdx.x; it < 576 + 192 + 768 + 384 + NT / CT; it += G) {
          if (it < 576) rwkv_scan(P, l, it, false, smem);
          else if (it < 768) fourier_tile(P, it - 576, smem);
          else if (it < 1536) gla_g2(P, l, it - 768, smem);
          else if (it < 1920) pool_tile(P, l, it - 1536, smem);
          else gatec_tile(P, l, it - 1920, smem);
        }
      }
    }
    gsync(P, epoch);
    REP(R_PREP) for (int it = blockIdx.x; it < NT / CT; it += G) combine_tile(P, l, it, smem);
#ifdef DUP_COMB
    for (int it = blockIdx.x; it < 384; it += G) combine_tile(P, l, it, smem);
#endif
    gsync(P, epoch);
    REP(R_GEMM) phase_gemm_mlog(P, smem, tl);
#ifdef DUP_GEMM
    phase_gemm_mlog(P, smem, tl);
#endif
    gsync(P, epoch);
    REP(R_GEMM) phase_merge(P, smem, tl);
#ifdef DUP_GEMM
    phase_merge(P, smem, tl);
#endif
    gsync(P, epoch);
    REP(R_GEMM) phase_gemm_res(P, l, 0, smem, rep > 0, tl);
    gsync(P, epoch);
    REP(R_NORM) phase_norm(P, l, 1);
    gsync(P, epoch);
    REP(R_GEMM) phase_mlp_up(P, smem, tl);
#ifdef DUP_GEMM
    phase_mlp_up(P, smem, tl);
#endif
    gsync(P, epoch);
    REP(R_GEMM) phase_gemm_res(P, l, 1, smem, rep > 0, tl);
    gsync(P, epoch);
  }
#ifdef R_SYNC
  for (int i = 0; i < R_SYNC + zero; ++i) gsync(P, epoch);
#endif
  phase_norm(P, 0, 2);
}

extern "C" void kernel_launch(void* const* d_in, const int* in_sizes, int n_in, void* d_out, int out_size, void* d_ws, size_t ws_size,
                              hipStream_t stream) {
  static int grid_blocks = 0;
  if (!grid_blocks) {
    int dev = 0, cus = 0, per_cu = 0;
    hipGetDevice(&dev);
    hipDeviceGetAttribute(&cus, hipDeviceAttributeMultiprocessorCount, dev);
    hipFuncSetAttribute((const void*)mega, hipFuncAttributeMaxDynamicSharedMemorySize, LDS_BYTES);
    hipOccupancyMaxActiveBlocksPerMultiprocessor(&per_cu, (const void*)mega, 256, LDS_BYTES);
    per_cu = 2;
    grid_blocks = cus * per_cu;
    if (ws_size < WS_END) fprintf(stderr, "kernel_launch: workspace too small: %zu < %llu\n", ws_size, (unsigned long long)WS_END);
  }
  Params p{};
  for (int i = 0; i < 31; ++i) p.in[i] = (const float*)d_in[i];
  p.out = (float*)d_out;
  p.ws_ = (unsigned char*)d_ws;
  hipMemsetAsync((unsigned char*)d_ws + OFF_BAR, 0, XCD_BAR_WORDS * 4, stream);
  void* args[] = {&p};
  hipError_t e = hipLaunchCooperativeKernel((const void*)mega, dim3(grid_blocks), dim3(256), args, LDS_BYTES, stream);
  if (e != hipSuccess) fprintf(stderr, "cooperative launch failed: %s (grid %d)\n", hipGetErrorString(e), grid_blocks);
}
```

```cpp
#define TILE_STRIP 6
#include <hip/hip_runtime.h>
#include <hip/hip_cooperative_groups.h>
#include <cstdio>
#include <cstdint>
namespace cg = cooperative_groups;

typedef unsigned short bf16_t;
typedef short bf16x8 __attribute__((ext_vector_type(8)));
typedef float f32x4 __attribute__((ext_vector_type(4)));

#define NT 12288
#define DM 1024
#define NU 2176
#define NWIN 6784
#define DFF 4096
#define UP 0
#define UR 256
#define UK 512
#define UV 768
#define UCW 1024
#define UCA 1152
#define UCG 1216
#define UGQ 1280
#define UGK 1408
#define UGV 1536
#define UGO 1792
#define UCAL 2048

#define OFF_MOD 0ull
#define OFF_TAB 147456ull
#define OFF_WIN 155648ull
#define OFF_WB 14049280ull
#define OFF_WO 16146432ull
#define OFF_W1 18243584ull
#define OFF_W2 26632192ull
#define OFF_H 35020800ull
#define OFF_U 60186624ull
#define OFF_ZT 113664000ull
#define OFF_YS 126246912ull
#define OFF_ORW 151412736ull
#define OFF_M 163995648ull
#define WS_END 264658944ull
#define M_R 0ull
#define M_V 6291456ull
#define M_KK 12582912ull
#define M_KD 18874368ull
#define M_B 31457280ull
#define M_W 44040192ull
#define M_OG 69206016ull
#define M_GS 81788928ull

#define OUT_SR 12582912ull
#define OUT_SG 13631488ull

#define LDS_BYTES 74256
#define LDS_TAB 66048

struct Params {
  const float* in[31];
  float* out;
  unsigned char* ws_;
};
enum { I_XP = 0, I_XS, I_SRW, I_SGL, I_C, I_CCTX, I_ADAW, I_ADAB, I_N1G, I_N2G, I_WIN, I_POOLW, I_POOLS, I_MU, I_W0, I_BW,
       I_A0, I_BA, I_KKP, I_KA, I_BG, I_RK, I_GN, I_GAB, I_GABIAS, I_GNORM, I_WBR, I_WOUT, I_W1, I_W2, I_FG };

__device__ __forceinline__ bf16_t f2bf(float f) {
  unsigned u = __float_as_uint(f);
  u += 0x7fffu + ((u >> 16) & 1u);
  return (bf16_t)(u >> 16);
}
__device__ __forceinline__ float bf2f(bf16_t h) { return __uint_as_float(((unsigned)h) << 16); }
__device__ __forceinline__ unsigned pk2(float a, float b) { return (unsigned)f2bf(a) | ((unsigned)f2bf(b) << 16); }
__device__ __forceinline__ float bflo(unsigned u) { return __uint_as_float(u << 16); }
__device__ __forceinline__ float bfhi(unsigned u) { return __uint_as_float(u & 0xffff0000u); }
__device__ __forceinline__ float sigmoidf_(float x) { return __frcp_rn(1.f + __expf(-x)); }
__device__ __forceinline__ float row16_sum(float v);
__device__ __forceinline__ float wave_sum(float v) {
  v = row16_sum(v);
  const int iv = __builtin_bit_cast(int, v);
  const float s0 = __builtin_bit_cast(float, __builtin_amdgcn_readlane(iv, 0)), s1 = __builtin_bit_cast(float, __builtin_amdgcn_readlane(iv, 16));
  const float s2 = __builtin_bit_cast(float, __builtin_amdgcn_readlane(iv, 32)), s3 = __builtin_bit_cast(float, __builtin_amdgcn_readlane(iv, 48));
  return (s0 + s1) + (s2 + s3);
}
__device__ __forceinline__ float row16_sum(float v) {
  v += __builtin_bit_cast(float, __builtin_amdgcn_update_dpp(0, __builtin_bit_cast(int, v), 0x128, 0xf, 0xf, false));
  v += __builtin_bit_cast(float, __builtin_amdgcn_update_dpp(0, __builtin_bit_cast(int, v), 0x124, 0xf, 0xf, false));
  v += __builtin_bit_cast(float, __builtin_amdgcn_update_dpp(0, __builtin_bit_cast(int, v), 0x122, 0xf, 0xf, false));
  v += __builtin_bit_cast(float, __builtin_amdgcn_update_dpp(0, __builtin_bit_cast(int, v), 0x121, 0xf, 0xf, false));
  return v;
}
#define DPP_ADD(v_, ctrl_) v_ += __builtin_bit_cast(float, __builtin_amdgcn_update_dpp(0, __builtin_bit_cast(int, v_), ctrl_, 0xf, 0xf, false))
__device__ __forceinline__ void row16_sum2(float& a, float& b) {
  DPP_ADD(a, 0x128); DPP_ADD(b, 0x128); DPP_ADD(a, 0x124); DPP_ADD(b, 0x124); DPP_ADD(a, 0x122); DPP_ADD(b, 0x122); DPP_ADD(a, 0x121); DPP_ADD(b, 0x121);
}
__device__ __forceinline__ void seq_of_tok(int tok, int& start, int& L, int& ci) {
  if (tok < 4096) { start = tok & ~255; L = 256; ci = 0; }
  else { int b = (tok - 4096) >> 12; start = 4096 + (b << 12); L = 4096; ci = 1 + b; }
}

__device__ __forceinline__ size_t oz0() { size_t z = 0; asm volatile("" : "+s"(z)); return z; }
#define PWS (P.ws_ + oz0())
__device__ __forceinline__ int otid() { int t = threadIdx.x; asm volatile("" : "+v"(t)); return t; }
template <int AMODE, int NF, int NK>
__device__ __forceinline__ void gemm_acc(f32x4 (&acc)[4][NF], const bf16_t* __restrict__ A, int lda, const bf16_t* __restrict__ B, int ldb,
                                         unsigned char* smem, int k1base = 0, int Lmask = 0, int sh = 0, int ph = 0, int nbase = 0) {
  const int tid = otid(), lane = tid & 63, wid = tid >> 6, wr = wid >> 1, wc = wid & 1;
  bf16_t* sA = (bf16_t*)smem;
  bf16_t* sB = (bf16_t*)(smem + 32768);
  const bf16_t* tab = (const bf16_t*)(smem + LDS_TAB);
  uint4 ra0x, ra1x, ra2x, ra3x, rb0x, rb1x, rb2x, rb3x, ra0y, ra1y, ra2y, ra3y, rb0y, rb1y, rb2y, rb3y;
  const int row0 = tid >> 3, kc0 = tid & 7;
  const int soff = row0 * 64 + ((kc0 ^ ((row0 >> 1) & 7)) << 3);
  const int rho0 = (((row0 >> 2) & 1) << 4) | ((row0 >> 3) << 2) | (row0 & 3);
  const int soffB = rho0 * 64 + ((kc0 ^ ((rho0 >> 1) & 7)) << 3);
  const bf16_t* Ap = A + (size_t)row0 * lda + kc0 * 8;
  const bf16_t* Bp = B + (size_t)row0 * ldb + kc0 * 8;
#define GL1(r_, P_, ld_, i_, kt_) r_ = *(const uint4*)(P_ + (size_t)(32 * i_) * ld_ + (kt_) * 64);
#define GLOAD(X, kt) { if (AMODE == 0) { GL1(ra0##X, Ap, lda, 0, kt) GL1(ra1##X, Ap, lda, 1, kt) GL1(ra2##X, Ap, lda, 2, kt) GL1(ra3##X, Ap, lda, 3, kt) } \
    GL1(rb0##X, Bp, ldb, 0, kt) GL1(rb1##X, Bp, ldb, 1, kt) if (NF == 4) { GL1(rb2##X, Bp, ldb, 2, kt) GL1(rb3##X, Bp, ldb, 3, kt) } }
#define TABV(dst_) { const unsigned lo = tab[((idx << sh) + ph) & 4095]; idx = (idx + k1) & Lmask; const unsigned hi = tab[((idx << sh) + ph) & 4095]; idx = (idx + k1) & Lmask; dst_ = lo | (hi << 16); }
#define GEN1(r_, i_, kt_) { const int k1 = k1base + row0 + 32 * i_, n = nbase + (kt_) * 64 + kc0 * 8; int idx = (k1 * n) & Lmask; TABV(r_.x) TABV(r_.y) TABV(r_.z) TABV(r_.w) }
#define SSTORE(X, buf, kt) { if (AMODE == 1) { GEN1(ra0##X, 0, kt) GEN1(ra1##X, 1, kt) GEN1(ra2##X, 2, kt) GEN1(ra3##X, 3, kt) } \
    *(uint4*)(sA + (buf) * 8192 + soff) = ra0##X; *(uint4*)(sA + (buf) * 8192 + soff + 2048) = ra1##X; *(uint4*)(sA + (buf) * 8192 + soff + 4096) = ra2##X; *(uint4*)(sA + (buf) * 8192 + soff + 6144) = ra3##X; \
    *(uint4*)(sB + (buf) * 8192 + soffB) = rb0##X; *(uint4*)(sB + (buf) * 8192 + soffB + 2048) = rb1##X; \
    if (NF == 4) { *(uint4*)(sB + (buf) * 8192 + soffB + 4096) = rb2##X; *(uint4*)(sB + (buf) * 8192 + soffB + 6144) = rb3##X; } }
#define COMPUTE(buf) { \
    _Pragma("unroll") for (int ks = 0; ks < 2; ++ks) { \
      bf16x8 af[4], bfr[NF]; \
      const int q = ks * 4 + (lane >> 4); \
      _Pragma("unroll") for (int m = 0; m < 4; ++m) { const int r = wr * 64 + m * 16 + (lane & 15); af[m] = *(const bf16x8*)(sA + (buf) * 8192 + r * 64 + ((q ^ ((r >> 1) & 7)) << 3)); } \
      _Pragma("unroll") for (int n = 0; n < NF; ++n) { const int r = wc * (NF * 16) + n * 16 + (lane & 15); bfr[n] = *(const bf16x8*)(sB + (buf) * 8192 + r * 64 + ((q ^ ((r >> 1) & 7)) << 3)); } \
      _Pragma("unroll") for (int m = 0; m < 4; ++m) \
        _Pragma("unroll") for (int n = 0; n < NF; ++n) acc[m][n] = __builtin_amdgcn_mfma_f32_16x16x32_bf16(bfr[n], af[m], acc[m][n], 0, 0, 0); \
    } }
  static_assert(NK >= 4 && (NK & 1) == 0, "NK even, >= 4");
  GLOAD(x, 0)
  GLOAD(y, 1)
  SSTORE(x, 0, 0)
  __syncthreads();
#pragma unroll
  for (int kt = 0; kt < NK - 2; kt += 2) {
    GLOAD(x, kt + 2)
    COMPUTE(0)
    SSTORE(y, 1, kt + 1)
    __syncthreads();
    GLOAD(y, kt + 3)
    COMPUTE(1)
    SSTORE(x, 0, kt + 2)
    __syncthreads();
  }
  COMPUTE(0)
  SSTORE(y, 1, NK - 1)
  __syncthreads();
  COMPUTE(1)
  __syncthreads();
#undef GLOAD
#undef SSTORE
#undef COMPUTE
#undef GL1
#undef TABV
#undef GEN1
}
#define ACC_ZERO(a) ACC_ZERO_N(a, 4)
#define ACC_ZERO_N(a, NF_) _Pragma("unroll") for (int m_ = 0; m_ < 4; ++m_) _Pragma("unroll") for (int n_ = 0; n_ < NF_; ++n_) a[m_][n_] = (f32x4){0.f, 0.f, 0.f, 0.f}
#define EPI_BEGIN(a) EPI_BEGIN_N(a, 4)
#define EPI_BEGIN_N(a, NF_) { const int t_ = otid(), lane_ = t_ & 63, wid_ = t_ >> 6, wr_ = wid_ >> 1, wc_ = wid_ & 1; \
  _Pragma("unroll") for (int m_ = 0; m_ < 4; ++m_) _Pragma("unroll") for (int p_ = 0; p_ < NF_ / 2; ++p_) { \
    const int r = wr_ * 64 + m_ * 16 + (lane_ & 15), c = wc_ * (NF_ * 16) + p_ * 32 + (lane_ >> 4) * 8; f32x4& v0 = a[m_][2 * p_]; f32x4& v1 = a[m_][2 * p_ + 1];
#define EPI_END }}

__device__ __forceinline__ void phase_mod(const Params& P, unsigned char* smem) {
  float* sc = (float*)smem;
  float* part = (float*)(smem + 12288);
  const int tid = otid(), lane = tid & 63, w = tid >> 6;
  float* mod = (float*)(PWS + OFF_MOD);
  if (blockIdx.x >= 192) return;
  for (int i = tid; i < 3072; i += 256) {
    const int ci = i >> 10, k = i & 1023;
    const float c = ci == 0 ? P.in[I_CCTX][k] : P.in[I_C][(ci - 1) * 1024 + k];
    sc[i] = c * sigmoidf_(c);
  }
  __syncthreads();
  for (int item = blockIdx.x; item < 192; item += gridDim.x) {
    const int l = item / 96, cb = item % 96, col = cb * 64 + lane;
    const float* W = P.in[I_ADAW] + (size_t)l * 1024 * 6144 + col;
    float a0 = 0.f, a1 = 0.f, a2 = 0.f;
#pragma unroll 8
    for (int k = w * 256; k < w * 256 + 256; ++k) {
      const float wv = W[(size_t)k * 6144];
      a0 += sc[k] * wv; a1 += sc[1024 + k] * wv; a2 += sc[2048 + k] * wv;
    }
    part[(w * 3 + 0) * 64 + lane] = a0; part[(w * 3 + 1) * 64 + lane] = a1; part[(w * 3 + 2) * 64 + lane] = a2;
    __syncthreads();
    if (tid < 192) {
      const int ci = tid >> 6;
      const float s = part[(0 * 3 + ci) * 64 + lane] + part[(1 * 3 + ci) * 64 + lane] + part[(2 * 3 + ci) * 64 + lane] + part[(3 * 3 + ci) * 64 + lane];
      mod[(size_t)(l * 3 + ci) * 6144 + col] = s + P.in[I_ADAB][l * 6144 + col];
    }
    __syncthreads();
  }
}

__device__ __forceinline__ void conv_tile(const float* __restrict__ W, int N, int K, int k0, int scol0, int nvalid, bf16_t* __restrict__ dst, int drow0, float* t) {
  const int tid = otid();
#pragma unroll
  for (int i = 0; i < 16; ++i) {
    const int kk = (tid >> 6) + 4 * i, j = tid & 63;
    t[kk * 65 + j] = (j < nvalid) ? W[(size_t)(k0 + kk) * N + scol0 + j] : 0.f;
  }
  __syncthreads();
  {
    const int n = tid >> 2, kq = (tid & 3) * 16;
    uint4 o0, o1;
    const float* s = t + kq * 65 + n;
    o0.x = pk2(s[0], s[65]); o0.y = pk2(s[130], s[195]); o0.z = pk2(s[260], s[325]); o0.w = pk2(s[390], s[455]);
    s += 8 * 65;
    o1.x = pk2(s[0], s[65]); o1.y = pk2(s[130], s[195]); o1.z = pk2(s[260], s[325]); o1.w = pk2(s[390], s[455]);
    uint4* d = (uint4*)(dst + (size_t)(drow0 + n) * K + k0 + kq);
    d[0] = o0; d[1] = o1;
  }
  __syncthreads();
}
__device__ __forceinline__ void fold_tile(const float* __restrict__ W, int N, int K, int k0, int scol0, int sn, bf16_t* __restrict__ dst, int drow0, float* t, float* t2, const float* ctab) {
  const int tid = otid();
#pragma unroll
  for (int i = 0; i < 16; ++i) {
    const int kk = (tid >> 6) + 4 * i, j = tid & 63;
    t[kk * 65 + j] = W[(size_t)(k0 + kk) * N + scol0 + j];
  }
  __syncthreads();
  {
    const int j = tid & 63, kq = tid >> 6;
    float acc[16];
#pragma unroll
    for (int u = 0; u < 16; ++u) acc[u] = 0.f;
    for (int i = 0; i < 64; ++i) {
      const float tv = ctab[(i * j - (sn ? 16 : 0)) & 63];
#pragma unroll
      for (int u = 0; u < 16; ++u) acc[u] += t[(kq * 16 + u) * 65 + i] * tv;
    }
    const float scl = sn ? -0.125f : 0.125f;
#pragma unroll
    for (int u = 0; u < 16; ++u) t2[(kq * 16 + u) * 65 + j] = acc[u] * scl;
  }
  __syncthreads();
  {
    const int n = tid >> 2, kq = (tid & 3) * 16;
    uint4 o0, o1;
    const float* s = t2 + kq * 65 + n;
    o0.x = pk2(s[0], s[65]); o0.y = pk2(s[130], s[195]); o0.z = pk2(s[260], s[325]); o0.w = pk2(s[390], s[455]);
    s += 8 * 65;
    o1.x = pk2(s[0], s[65]); o1.y = pk2(s[130], s[195]); o1.z = pk2(s[260], s[325]); o1.w = pk2(s[390], s[455]);
    uint4* d = (uint4*)(dst + (size_t)(drow0 + n) * K + k0 + kq);
    d[0] = o0; d[1] = o1;
  }
  __syncthreads();
}

#define CONV_ITEMS 4256
__device__ __forceinline__ void phase_convert(const Params& P, int l, unsigned char* smem, int first, int stride) {
  float* t = (float*)smem;
  float* t2 = (float*)(smem + 16640);
  float* ctab = (float*)(smem + 33280);
  { const int tq = otid(); if (tq < 64) ctab[tq] = cosf(6.283185307179586f * (float)tq / 64.f); }
  __syncthreads();
  bf16_t* WIN = (bf16_t*)(PWS + OFF_WIN);
  for (int it = first; it < CONV_ITEMS; it += stride) {
    int r = it;
    if (r < 1696) {
      const int nt = r >> 4, kt = r & 15, np = nt * 64;
      const float* W = P.in[I_WIN] + (size_t)l * 1024 * 6432;
      if (np >= 2176 && np < 2688) {
        const int z = (np - 2176) >> 6, sn = z >> 2, g = z & 3;
        fold_tile(W, 6432, 1024, kt * 64, 256 + g * 64, sn, WIN, np, t, t2, ctab);
      } else {
        int scol, nvalid = 64;
        if (np < 256) scol = np;
        else if (np < 2080) { scol = np + 256; if (np + 64 > 2080) nvalid = 2080 - np; }
        else if (np < 2176) { scol = 0; nvalid = 0; }
        else scol = np - 352;
        conv_tile(W, 6432, 1024, kt * 64, scol, nvalid, WIN, np, t);
      }
      continue;
    }
    r -= 1696;
    if (r < 256) { conv_tile(P.in[I_WBR] + (size_t)l * 1024 * 1024, 1024, 1024, (r & 15) * 64, (r >> 4) * 64, 64, (bf16_t*)(PWS + OFF_WB), (r >> 4) * 64, t); continue; }
    r -= 256;
    if (r < 256) { conv_tile(P.in[I_WOUT] + (size_t)l * 1024 * 1024, 1024, 1024, (r & 15) * 64, (r >> 4) * 64, 64, (bf16_t*)(PWS + OFF_WO), (r >> 4) * 64, t); continue; }
    r -= 256;
    if (r < 1024) { conv_tile(P.in[I_W1] + (size_t)l * 1024 * 4096, 4096, 1024, (r & 15) * 64, (r >> 4) * 64, 64, (bf16_t*)(PWS + OFF_W1), (r >> 4) * 64, t); continue; }
    r -= 1024;
    conv_tile(P.in[I_W2] + (size_t)l * 4096 * 1024, 1024, 4096, (r & 63) * 64, (r >> 6) * 64, 64, (bf16_t*)(PWS + OFF_W2), (r >> 6) * 64, t);
  }
}
__device__ __forceinline__ void phase_table(const Params& P) {
  if (blockIdx.x == gridDim.x - 1) {
    bf16_t* tab = (bf16_t*)(PWS + OFF_TAB);
    for (int i = otid(); i < 4096; i += 256) tab[i] = f2bf(cosf(6.283185307179586f * (float)i / 4096.f));
  }
}

__device__ __forceinline__ void phase_norm(const Params& P, int l, int which) {
  const int tid = otid(), lane = tid & 63, gw = blockIdx.x * 4 + (tid >> 6), nw = gridDim.x * 4;
  const float* mod = (const float*)(PWS + OFF_MOD);
  bf16_t* H = (bf16_t*)(PWS + OFF_H);
  float omega[4] = {0.f, 0.f, 0.f, 0.f};
  if (which == 0 && l == 0) {
#pragma unroll
    for (int e = 0; e < 4; ++e) omega[e] = 1.0f / powf(10000.0f, (float)(lane * 4 + e) / 256.0f);
  }
  for (int tok = gw; tok < NT; tok += nw) {
    int start, L, ci; seq_of_tok(tok, start, L, ci);
    float* xr = P.out + (size_t)tok * 1024;
    f32x4 v[4];
    if (which == 0 && l == 0) {
      const float* src = tok < 4096 ? P.in[I_XP] + (size_t)tok * 1024 : P.in[I_XS] + (size_t)(tok - 4096) * 1024;
      const int n = tok - start;
#pragma unroll
      for (int j = 0; j < 4; ++j) {
        v[j] = *(const f32x4*)(src + j * 256 + lane * 4);
        if (tok >= 4096) {
          const float pos = (j < 2) ? (float)(n >> 6) : (float)(n & 63);
#pragma unroll
          for (int e = 0; e < 4; ++e) {
            const float ang = pos * omega[e];
            v[j][e] += (j & 1) ? cosf(ang) : sinf(ang);
          }
        }
        *(f32x4*)(xr + j * 256 + lane * 4) = v[j];
      }
    } else {
#pragma unroll
      for (int j = 0; j < 4; ++j) v[j] = *(const f32x4*)(xr + j * 256 + lane * 4);
    }
    float ss = 0.f;
#pragma unroll
    for (int j = 0; j < 4; ++j) ss += v[j][0] * v[j][0] + v[j][1] * v[j][1] + v[j][2] * v[j][2] + v[j][3] * v[j][3];
    ss = wave_sum(ss);
    const float rs = rsqrtf(ss * (1.f / 1024.f) + 1e-6f);
    if (which == 2) {
#pragma unroll
      for (int j = 0; j < 4; ++j) {
        const f32x4 g = *(const f32x4*)(P.in[I_FG] + j * 256 + lane * 4);
        f32x4 o;
#pragma unroll
        for (int e = 0; e < 4; ++e) o[e] = v[j][e] * rs * g[e];
        *(f32x4*)(xr + j * 256 + lane * 4) = o;
      }
    } else {
      const float* gsrc = (which == 0 ? P.in[I_N1G] : P.in[I_N2G]) + l * 1024;
      const float* mrow = mod + (size_t)(l * 3 + ci) * 6144 + (which == 0 ? 0 : 3072);
#pragma unroll
      for (int j = 0; j < 4; ++j) {
        const int c0 = j * 256 + lane * 4;
        const f32x4 g = *(const f32x4*)(gsrc + c0), shv = *(const f32x4*)(mrow + c0), scv = *(const f32x4*)(mrow + 1024 + c0);
        float o[4];
#pragma unroll
        for (int e = 0; e < 4; ++e) o[e] = v[j][e] * rs * g[e] * (1.f + scv[e]) + shv[e];
        uint2 pk; pk.x = pk2(o[0], o[1]); pk.y = pk2(o[2], o[3]);
        *(uint2*)(H + (size_t)tok * 1024 + c0) = pk;
      }
    }
  }
}

struct TL { int x, j, n; };
#define TILE_LOOP(NTN_) for (int q_ = tl.j, x_ = tl.x, nl_ = tl.n, NTN__ = (NTN_); q_ < 12 * (NTN_); q_ += nl_)
#ifdef TILE_STRIP
#define TILE_MT (12 * x_ + (q_ / (TILE_STRIP * NTN__)) * TILE_STRIP + q_ % TILE_STRIP)
#define TILE_NT ((q_ % (TILE_STRIP * NTN__)) / TILE_STRIP)
#else
#define TILE_MT (12 * x_ + q_ % 12)
#define TILE_NT (q_ / 12)
#endif
__device__ __forceinline__ void phase_gemm1(const Params& P, unsigned char* smem, const TL& tl) {
  const bf16_t* H = (const bf16_t*)(PWS + OFF_H);
  const bf16_t* WIN = (const bf16_t*)(PWS + OFF_WIN);
  bf16_t* U = (bf16_t*)(PWS + OFF_U);
  bf16_t* ZT = (bf16_t*)(PWS + OFF_ZT);
  TILE_LOOP(21) {
    const int mt = TILE_MT, nt = TILE_NT, m0 = mt * 128;
    f32x4 acc[4][4]; ACC_ZERO(acc);
    if (nt < 17) {
      gemm_acc<0, 4, 16>(acc, H + (size_t)m0 * 1024, 1024, WIN + (size_t)nt * 128 * 1024, 1024, smem);
      EPI_BEGIN(acc)
        uint4 pk; pk.x = pk2(v0[0], v0[1]); pk.y = pk2(v0[2], v0[3]); pk.z = pk2(v1[0], v1[1]); pk.w = pk2(v1[2], v1[3]);
        *(uint4*)(U + (size_t)(m0 + r) * NU + nt * 128 + c) = pk;
      EPI_END
    } else {
      const int z0 = (nt - 17) * 128;
      gemm_acc<0, 4, 16>(acc, WIN + (size_t)(2176 + z0) * 1024, 1024, H + (size_t)m0 * 1024, 1024, smem);
      EPI_BEGIN(acc)
        uint4 pk; pk.x = pk2(v0[0], v0[1]); pk.y = pk2(v0[2], v0[3]); pk.z = pk2(v1[0], v1[1]); pk.w = pk2(v1[2], v1[3]);
        *(uint4*)(ZT + (size_t)(z0 + r) * NT + m0 + c) = pk;
      EPI_END
    }
  }
}
__device__ __forceinline__ void phase_gemm_mlog(const Params& P, unsigned char* smem, const TL& tl) {
  const bf16_t* H = (const bf16_t*)(PWS + OFF_H);
  const bf16_t* WIN = (const bf16_t*)(PWS + OFF_WIN);
  bf16_t* Mg = (bf16_t*)(PWS + OFF_M);
  TILE_LOOP(32) {
    const int mt = TILE_MT, nt = TILE_NT, m0 = mt * 128;
    f32x4 acc[4][4]; ACC_ZERO(acc);
    gemm_acc<0, 4, 16>(acc, H + (size_t)m0 * 1024, 1024, WIN + (size_t)(2688 + nt * 128) * 1024, 1024, smem);
    EPI_BEGIN(acc)
      uint4 pk; pk.x = pk2(v0[0], v0[1]); pk.y = pk2(v0[2], v0[3]); pk.z = pk2(v1[0], v1[1]); pk.w = pk2(v1[2], v1[3]);
      *(uint4*)(Mg + (size_t)(m0 + r) * 4096 + nt * 128 + c) = pk;
    EPI_END
  }
}
__device__ __forceinline__ void phase_merge(const Params& P, unsigned char* smem, const TL& tl) {
  const bf16_t* YS = (const bf16_t*)(PWS + OFF_YS);
  const bf16_t* WB = (const bf16_t*)(PWS + OFF_WB);
  const bf16_t* Mg = (const bf16_t*)(PWS + OFF_M);
  bf16_t* MG = (bf16_t*)(PWS + OFF_U);
  TILE_LOOP(16) {
    const int mt = TILE_MT, nt = TILE_NT, m0 = mt * 128, n0 = nt * 64;
    f32x4 macc[4][2]; ACC_ZERO_N(macc, 2);
    const int t_ = otid(), lane_ = t_ & 63, wid_ = t_ >> 6, wr_ = wid_ >> 1, wc_ = wid_ & 1;
    const bf16_t* gp = Mg + (size_t)(m0 + wr_ * 64 + (lane_ & 15)) * 4096 + n0 + wc_ * 32 + (lane_ >> 4) * 8;
#define MROW(m, gX) { const uint4 gv = gX; \
      macc[m][0][0] += sigmoidf_(bflo(gv.x)) * acc[m][0][0]; macc[m][0][1] += sigmoidf_(bfhi(gv.x)) * acc[m][0][1]; \
      macc[m][0][2] += sigmoidf_(bflo(gv.y)) * acc[m][0][2]; macc[m][0][3] += sigmoidf_(bfhi(gv.y)) * acc[m][0][3]; \
      macc[m][1][0] += sigmoidf_(bflo(gv.z)) * acc[m][1][0]; macc[m][1][1] += sigmoidf_(bfhi(gv.z)) * acc[m][1][1]; \
      macc[m][1][2] += sigmoidf_(bflo(gv.w)) * acc[m][1][2]; macc[m][1][3] += sigmoidf_(bfhi(gv.w)) * acc[m][1][3]; }
#pragma unroll 1
    for (int i = 0; i < 4; ++i) {
      f32x4 acc[4][2]; ACC_ZERO_N(acc, 2);
      const uint4 g0 = *(const uint4*)(gp + i * 1024), g1 = *(const uint4*)(gp + (size_t)16 * 4096 + i * 1024),
                  g2 = *(const uint4*)(gp + (size_t)32 * 4096 + i * 1024), g3 = *(const uint4*)(gp + (size_t)48 * 4096 + i * 1024);
      gemm_acc<0, 2, 4>(acc, YS + (size_t)m0 * 1024 + i * 256, 1024, WB + (size_t)n0 * 1024 + i * 256, 1024, smem);
      MROW(0, g0) MROW(1, g1) MROW(2, g2) MROW(3, g3)
    }
#undef MROW
    EPI_BEGIN_N(macc, 2)
      uint4 pk; pk.x = pk2(v0[0], v0[1]); pk.y = pk2(v0[2], v0[3]); pk.z = pk2(v1[0], v1[1]); pk.w = pk2(v1[2], v1[3]);
      *(uint4*)(MG + (size_t)(m0 + r) * 1024 + n0 + c) = pk;
    EPI_END
  }
}
__device__ __forceinline__ void phase_gemm_res(const Params& P, int l, int which, unsigned char* smem, bool dry, const TL& tl) {
  const bf16_t* A = (const bf16_t*)(PWS + (which == 0 ? OFF_U : OFF_M));
  const bf16_t* W = (const bf16_t*)(PWS + (which == 0 ? OFF_WO : OFF_W2));
  const int K = which == 0 ? 1024 : 4096;
  const float* mod = (const float*)(PWS + OFF_MOD);
  TILE_LOOP(16) {
    const int mt = TILE_MT, nt = TILE_NT, m0 = mt * 128, n0 = nt * 64;
    int start, L, ci; seq_of_tok(m0, start, L, ci);
    const float* gate = mod + (size_t)(l * 3 + ci) * 6144 + (which == 0 ? 2048 : 5120);
    f32x4 acc[4][2]; ACC_ZERO_N(acc, 2);
    #pragma unroll 1
    for (int kc = 0; kc < K; kc += 1024) gemm_acc<0, 2, 16>(acc, A + (size_t)m0 * K + kc, K, W + (size_t)n0 * K + kc, K, smem);
    EPI_BEGIN_N(acc, 2)
      float* xp = P.out + (size_t)(m0 + r) * 1024 + n0 + c;
      const f32x4 g0 = *(const f32x4*)(gate + n0 + c), g1 = *(const f32x4*)(gate + n0 + c + 4);
      f32x4 x0 = *(const f32x4*)xp, x1 = *(const f32x4*)(xp + 4);
      x0[0] += g0[0] * v0[0]; x0[1] += g0[1] * v0[1]; x0[2] += g0[2] * v0[2]; x0[3] += g0[3] * v0[3];
      x1[0] += g1[0] * v1[0]; x1[1] += g1[1] * v1[1]; x1[2] += g1[2] * v1[2]; x1[3] += g1[3] * v1[3];
      if (!dry) { *(f32x4*)xp = x0; *(f32x4*)(xp + 4) = x1; }
    EPI_END
  }
}
__device__ __forceinline__ void phase_mlp_up(const Params& P, unsigned char* smem, const TL& tl) {
  const bf16_t* H = (const bf16_t*)(PWS + OFF_H);
  const bf16_t* W1 = (const bf16_t*)(PWS + OFF_W1);
  bf16_t* HID = (bf16_t*)(PWS + OFF_M);
  TILE_LOOP(32) {
    const int mt = TILE_MT, nt = TILE_NT, m0 = mt * 128;
    f32x4 acc[4][4]; ACC_ZERO(acc);
    gemm_acc<0, 4, 16>(acc, H + (size_t)m0 * 1024, 1024, W1 + (size_t)nt * 128 * 1024, 1024, smem);
    EPI_BEGIN(acc)
      float o[8];
#pragma unroll
      for (int e = 0; e < 4; ++e) { const float a = fmaxf(v0[e], 0.f), b = fmaxf(v1[e], 0.f); o[e] = a * a; o[4 + e] = b * b; }
      uint4 pk; pk.x = pk2(o[0], o[1]); pk.y = pk2(o[2], o[3]); pk.z = pk2(o[4], o[5]); pk.w = pk2(o[6], o[7]);
      *(uint4*)(HID + (size_t)(m0 + r) * 4096 + nt * 128 + c) = pk;
    EPI_END
  }
}

__device__ __forceinline__ void pool_tile(const Params& P, int l, int tile, unsigned char* smem) {
  const int tid = otid(), tok0 = tile * 32;
  int start, L, ci; seq_of_tok(tok0, start, L, ci);
  const bf16_t* U = (const bf16_t*)(PWS + OFF_U);
  bf16_t* YS = (bf16_t*)(PWS + OFF_YS);
  float* pl = (float*)smem;
  bf16_t* zw = (bf16_t*)(smem + 32768);
  float* tw = (float*)(smem + 32768);
  float* ca = (float*)(smem + 49152);
  const int col = tid, g = col >> 6;
#pragma unroll
  for (int i = 0; i < 6; ++i) {
    const int c = tid + 256 * i;
    if (c < 47 * 32) {
      const int rr = c >> 5, cc = (c & 31) * 8, t = tok0 - 8 + rr - start;
      uint4 v = make_uint4(0u, 0u, 0u, 0u);
      if (t >= 0 && t < L) v = *(const uint4*)(U + (size_t)(start + t) * NU + UP + cc);
      *(uint4*)(zw + rr * 256 + cc) = v;
    }
  }
  __syncthreads();
  {
    const int half = 1 << g, win = 2 << g;
#pragma unroll 4
    for (int tt = 0; tt < 32; ++tt) {
      const int t = tok0 + tt - start;
      const int lo = max(t - half, 0), hi = min(t + half - 1, L - 1);
      float s = 0.f;
      const bf16_t* zp = zw + (tt + 8 - half) * 256 + col;
      for (int p = 0; p < win; ++p) s += bf2f(zp[p * 256]);
      pl[tt * 256 + col] = s / (float)(hi - lo + 1) - bf2f(zw[(tt + 8) * 256 + col]);
    }
  }
  __syncthreads();
  {
    float wreg[64];
    const float* pw = P.in[I_POOLW] + (size_t)(l * 4 + g) * 4096 + (col & 63);
#pragma unroll
    for (int cc = 0; cc < 64; ++cc) wreg[cc] = pw[cc * 64];
    const float ps = P.in[I_POOLS][l * 256 + col];
#pragma unroll 2
    for (int tt = 0; tt < 32; ++tt) {
      float a0 = 0.f, a1 = 0.f;
#pragma unroll
      for (int c4 = 0; c4 < 16; ++c4) {
        const f32x4 p4 = *(const f32x4*)(pl + tt * 256 + g * 64 + c4 * 4);
        a0 += p4[0] * wreg[c4 * 4] + p4[2] * wreg[c4 * 4 + 2];
        a1 += p4[1] * wreg[c4 * 4 + 1] + p4[3] * wreg[c4 * 4 + 3];
      }
      YS[(size_t)(tok0 + tt) * 1024 + col] = f2bf((a0 + a1) * ps);
    }
  }
  __syncthreads();
}
__device__ __forceinline__ void prep_tile(const Params& P, int l, int tile, unsigned char* smem) {
  const int tid = otid(), tok0 = tile * 32;
  int start, L, ci; seq_of_tok(tok0, start, L, ci);
  const bf16_t* U = (const bf16_t*)(PWS + OFF_U);
  bf16_t* YS = (bf16_t*)(PWS + OFF_YS);
  float* pl = (float*)smem;
  bf16_t* zw = (bf16_t*)(smem + 32768);
  float* tw = (float*)(smem + 32768);
  float* ca = (float*)(smem + 49152);
  const int col = tid, g = col >> 6;
#pragma unroll
  for (int i = 0; i < 3; ++i) {
    const int c = tid + 256 * i, tt = c / 24, j8 = (c % 24) * 8;
    const uint4 v = *(const uint4*)(U + (size_t)(tok0 + tt) * NU + UCW + j8);
    const unsigned w4[4] = {v.x, v.y, v.z, v.w};
#pragma unroll
    for (int e2 = 0; e2 < 4; ++e2) {
      const float x0 = bflo(w4[e2]), x1 = bfhi(w4[e2]);
      const int jj = j8 + 2 * e2;
      if (jj < 128) { tw[tt * 128 + jj] = 1.f - 2.f * __frcp_rn(1.f + __expf(2.f * x0)); tw[tt * 128 + jj + 1] = 1.f - 2.f * __frcp_rn(1.f + __expf(2.f * x1)); }
      else { ca[tt * 64 + jj - 128] = x0; ca[tt * 64 + jj - 127] = x1; }
    }
  }
  __syncthreads();
  float* Wd = (float*)(PWS + OFF_M + M_W);
  float aF[32], aB[32];
#pragma unroll 1
  for (int dir = 0; dir < 2; ++dir) {
    {
      float wreg[64];
      const float* bw = P.in[I_BW] + (size_t)(l * 2 + dir) * 64 * 256 + col;
#pragma unroll
      for (int r = 0; r < 64; ++r) wreg[r] = bw[r * 256];
      const float w0 = P.in[I_W0][(l * 2 + dir) * 256 + col];
#pragma unroll 2
      for (int tt = 0; tt < 32; ++tt) {
        float a0 = w0, a1 = 0.f;
#pragma unroll
        for (int r4 = 0; r4 < 16; ++r4) {
          const f32x4 x4 = *(const f32x4*)(tw + tt * 128 + dir * 64 + r4 * 4);
          a0 += x4[0] * wreg[r4 * 4] + x4[2] * wreg[r4 * 4 + 2];
          a1 += x4[1] * wreg[r4 * 4 + 1] + x4[3] * wreg[r4 * 4 + 3];
        }
        Wd[((size_t)dir * NT + tok0 + tt) * 256 + col] = __expf(-0.606531f * sigmoidf_(a0 + a1));
      }
    }
    {
      float wreg[32];
      const float* ba = P.in[I_BA] + (size_t)(l * 2 + dir) * 32 * 256 + col;
#pragma unroll
      for (int r = 0; r < 32; ++r) wreg[r] = ba[r * 256];
      const float a0c = P.in[I_A0][(l * 2 + dir) * 256 + col];
#pragma unroll
      for (int tt = 0; tt < 32; ++tt) {
        float a0 = a0c, a1 = 0.f;
#pragma unroll
        for (int r4 = 0; r4 < 8; ++r4) {
          const f32x4 x4 = *(const f32x4*)(ca + tt * 64 + dir * 32 + r4 * 4);
          a0 += x4[0] * wreg[r4 * 4] + x4[2] * wreg[r4 * 4 + 2];
          a1 += x4[1] * wreg[r4 * 4 + 1] + x4[3] * wreg[r4 * 4 + 3];
        }
        const float a = sigmoidf_(a0 + a1);
        if (dir == 0) aF[tt] = a; else aB[tt] = a;
      }
    }
  }
  {
    bf16_t* Rr = (bf16_t*)(PWS + OFF_M + M_R);
    bf16_t* Vv = (bf16_t*)(PWS + OFF_M + M_V);
    bf16_t* KKn = (bf16_t*)(PWS + OFF_M + M_KK);
    bf16_t* KD = (bf16_t*)(PWS + OFF_M + M_KD);
    bf16_t* Bb = (bf16_t*)(PWS + OFF_M + M_B);
    float* ORW = (float*)(PWS + OFF_ORW);
    const float mur = P.in[I_MU][l * 768 + col], muk = P.in[I_MU][l * 768 + 256 + col], muv = P.in[I_MU][l * 768 + 512 + col];
    const float kkp = P.in[I_KKP][l * 256 + col], ka = P.in[I_KA][l * 256 + col];
#pragma unroll
    for (int tt = 0; tt < 32; ++tt) {
      const int tok = tok0 + tt, t = tok - start;
      const bf16_t* u0 = U + (size_t)tok * NU;
      const float zr = bf2f(u0[UR + col]), zk = bf2f(u0[UK + col]), zv = bf2f(u0[UV + col]);
      float pr = 0.f, pk = 0.f, pv = 0.f, nr = 0.f, nk = 0.f, nv = 0.f;
      if (t > 0) { pr = bf2f(u0[UR + col - NU]); pk = bf2f(u0[UK + col - NU]); pv = bf2f(u0[UV + col - NU]); }
      if (t < L - 1) { nr = bf2f(u0[UR + col + NU]); nk = bf2f(u0[UK + col + NU]); nv = bf2f(u0[UV + col + NU]); }
      const float r = zr + mur * (0.5f * (pr + nr) - zr);
      const float k = zk + muk * (0.5f * (pk + nk) - zk);
      const float v = zv + muv * (0.5f * (pv + nv) - zv);
      float kk = k * kkp;
      const float ss = wave_sum(kk * kk);
      kk *= rsqrtf(ss + 1e-6f);
      const size_t o = (size_t)tok * 256 + col;
      Rr[o] = f2bf(r); Vv[o] = f2bf(v); KKn[o] = f2bf(kk);
      KD[o] = f2bf(k * (1.f + (aF[tt] - 1.f) * ka)); KD[(size_t)NT * 256 + o] = f2bf(k * (1.f + (aB[tt] - 1.f) * ka));
      Bb[o] = f2bf(kk * aF[tt]); Bb[(size_t)NT * 256 + o] = f2bf(kk * aB[tt]);
      ORW[o] = 0.f;
    }
  }
  __syncthreads();
}

__device__ __forceinline__ void gla_bcum(const Params& P, int l, int dir, int h, int c0, float* gs) {
  const int tid = otid();
  const bf16_t* U = (const bf16_t*)(PWS + OFF_U);
  {
    const int pp = tid >> 2, dq = tid & 3, tok = dir ? c0 + 63 - pp : c0 + pp;
    const uint4* cp = (const uint4*)(U + (size_t)tok * NU + UCAL + dir * 16);
    const uint4 c0v = cp[0], c1v = cp[1];
    float cal[16];
    cal[0] = bflo(c0v.x); cal[1] = bfhi(c0v.x); cal[2] = bflo(c0v.y); cal[3] = bfhi(c0v.y); cal[4] = bflo(c0v.z); cal[5] = bfhi(c0v.z); cal[6] = bflo(c0v.w); cal[7] = bfhi(c0v.w);
    cal[8] = bflo(c1v.x); cal[9] = bfhi(c1v.x); cal[10] = bflo(c1v.y); cal[11] = bfhi(c1v.y); cal[12] = bflo(c1v.z); cal[13] = bfhi(c1v.z); cal[14] = bflo(c1v.w); cal[15] = bfhi(c1v.w);
    const float* ab = P.in[I_GAB] + (size_t)(l * 2 + dir) * 16 * 128 + h * 32 + dq * 8;
    const float* bias = P.in[I_GABIAS] + (l * 2 + dir) * 128 + h * 32 + dq * 8;
#pragma unroll
    for (int dd = 0; dd < 8; ++dd) {
      float x = bias[dd];
#pragma unroll
      for (int r = 0; r < 16; ++r) x += cal[r] * ab[r * 128 + dd];
      const float ls = fminf(x, 0.f) - __logf(1.f + __expf(-fabsf(x)));
      gs[pp * 32 + dq * 8 + dd] = ls * (1.f / 16.f);
    }
  }
  __syncthreads();
  {
    float* segs = gs + 10240;
    const int d = tid & 31, sg_ = tid >> 5;
    float v[8], run = 0.f;
#pragma unroll
    for (int i = 0; i < 8; ++i) { run += gs[(sg_ * 8 + i) * 32 + d]; v[i] = run; }
    segs[sg_ * 32 + d] = run;
    __syncthreads();
    float off = 0.f;
#pragma unroll
    for (int s2 = 0; s2 < 7; ++s2) off += (s2 < sg_) ? segs[s2 * 32 + d] : 0.f;
#pragma unroll
    for (int i = 0; i < 8; ++i) gs[(sg_ * 8 + i) * 32 + d] = v[i] + off;
  }
  __syncthreads();
}
__device__ __forceinline__ void gla_g1(const Params& P, int l, int item, unsigned char* smem) {
  const int tid = otid();
  const int dir = item & 1, h = (item >> 1) & 3, cgi = item >> 3, c0 = cgi * 64;
  const bf16_t* U = (const bf16_t*)(PWS + OFF_U);
  float* gs = (float*)smem;
  float* kt = (float*)(smem + 8192);
  float* vs = (float*)(smem + 16384);
  gla_bcum(P, l, dir, h, c0, gs);
  {
    const int pp = tid >> 2, q4 = tid & 3, tok = dir ? c0 + 63 - pp : c0 + pp;
    const uint4 kv = *(const uint4*)(U + (size_t)tok * NU + UGK + h * 32 + q4 * 8);
    const unsigned kw[4] = {kv.x, kv.y, kv.z, kv.w};
#pragma unroll
    for (int i = 0; i < 4; ++i) {
      const int d = q4 * 8 + 2 * i;
      kt[pp * 32 + d] = bflo(kw[i]) * __expf(gs[63 * 32 + d] - gs[pp * 32 + d]);
      kt[pp * 32 + d + 1] = bfhi(kw[i]) * __expf(gs[63 * 32 + d + 1] - gs[pp * 32 + d + 1]);
    }
    const uint4* vp = (const uint4*)(U + (size_t)tok * NU + UGV + h * 64 + q4 * 16);
    const uint4 v0 = vp[0], v1 = vp[1];
    const unsigned vw[8] = {v0.x, v0.y, v0.z, v0.w, v1.x, v1.y, v1.z, v1.w};
#pragma unroll
    for (int i = 0; i < 8; ++i) { vs[pp * 64 + q4 * 16 + 2 * i] = bflo(vw[i]); vs[pp * 64 + q4 * 16 + 2 * i + 1] = bfhi(vw[i]); }
  }
  __syncthreads();
  {
    const int e = tid & 63, dq = tid >> 6;
    float acc[8];
#pragma unroll
    for (int dd = 0; dd < 8; ++dd) acc[dd] = 0.f;
    for (int pp = 0; pp < 64; ++pp) {
      const float vv = vs[pp * 64 + e];
#pragma unroll
      for (int dd = 0; dd < 8; ++dd) acc[dd] += kt[pp * 32 + dq * 8 + dd] * vv;
    }
    float* S = (float*)(PWS + OFF_M + M_GS) + (size_t)item * 2080;
#pragma unroll
    for (int dd = 0; dd < 8; ++dd) S[(dq * 8 + dd) * 64 + e] = acc[dd];
    if (tid < 32) S[2048 + tid] = __expf(gs[63 * 32 + tid]);
  }
  __syncthreads();
}
__device__ __forceinline__ void gla_g2(const Params& P, int l, int item, unsigned char* smem) {
  const int tid = otid();
  const int h = item & 3, cgi = item >> 2, c0 = cgi * 64;
  int start, L, ci; seq_of_tok(c0, start, L, ci);
  const int cfirst = start >> 6, nc = L >> 6;
  const bf16_t* U = (const bf16_t*)(PWS + OFF_U);
  const float* GS = (const float*)(PWS + OFF_M + M_GS);
  float* gs = (float*)smem;
  float* qt = (float*)(smem + 8192);
  float* kt = (float*)(smem + 16384);
  float* vs = (float*)(smem + 24576);
  float* att = (float*)(smem + 40960);
  float* Sp = (float*)(smem + 57600);
  const int e = tid & 63, pq = tid >> 6;
  float oacc[16];
#pragma unroll
  for (int i = 0; i < 16; ++i) oacc[i] = 0.f;
#pragma unroll 1
  for (int dir = 0; dir < 2; ++dir) {
    gla_bcum(P, l, dir, h, c0, gs);
    {
      float S[8];
      if (ci == 0) {
#pragma unroll
        for (int dd = 0; dd < 8; ++dd) S[dd] = 0.f;
      } else {
        const float* s0 = P.in[I_SGL] + ((((size_t)(ci - 1) * 2 + l) * 2 + dir) * 4 + h) * 2048;
#pragma unroll
        for (int dd = 0; dd < 8; ++dd) S[dd] = s0[(pq * 8 + dd) * 64 + e];
      }
      if (dir == 0) {
        for (int j = cfirst; j < cgi; ++j) {
          const float* sj = GS + (size_t)((j * 4 + h) * 2 + 0) * 2080;
#pragma unroll
          for (int dd = 0; dd < 8; ++dd) S[dd] = sj[2048 + pq * 8 + dd] * S[dd] + sj[(pq * 8 + dd) * 64 + e];
        }
      } else {
        for (int j = cfirst + nc - 1; j > cgi; --j) {
          const float* sj = GS + (size_t)((j * 4 + h) * 2 + 1) * 2080;
#pragma unroll
          for (int dd = 0; dd < 8; ++dd) S[dd] = sj[2048 + pq * 8 + dd] * S[dd] + sj[(pq * 8 + dd) * 64 + e];
        }
      }
#pragma unroll
      for (int dd = 0; dd < 8; ++dd) Sp[(pq * 8 + dd) * 64 + e] = S[dd];
      const bool last = dir == 0 ? (cgi == cfirst + nc - 1) : (cgi == cfirst);
      if (ci == 0 && last) {
        const float* sj = GS + (size_t)((cgi * 4 + h) * 2 + dir) * 2080;
        const int b = start >> 8;
        float* dst = P.out + OUT_SG + ((((size_t)b * 2 + l) * 2 + dir) * 4 + h) * 2048;
#pragma unroll
        for (int dd = 0; dd < 8; ++dd) dst[(pq * 8 + dd) * 64 + e] = sj[2048 + pq * 8 + dd] * S[dd] + sj[(pq * 8 + dd) * 64 + e];
      }
    }
    {
      const int pp = tid >> 2, q4 = tid & 3, tok = dir ? c0 + 63 - pp : c0 + pp;
      const uint4 qv = *(const uint4*)(U + (size_t)tok * NU + UGQ + h * 32 + q4 * 8);
      const uint4 kv = *(const uint4*)(U + (size_t)tok * NU + UGK + h * 32 + q4 * 8);
      const unsigned qw[4] = {qv.x, qv.y, qv.z, qv.w};
      const unsigned kw[4] = {kv.x, kv.y, kv.z, kv.w};
#pragma unroll
      for (int i = 0; i < 4; ++i) {
        const int d = q4 * 8 + 2 * i;
        const float b0 = gs[pp * 32 + d], b1 = gs[pp * 32 + d + 1];
        qt[pp * 32 + d] = bflo(qw[i]) * 0.17677669529663687f * __expf(b0);
        qt[pp * 32 + d + 1] = bfhi(qw[i]) * 0.17677669529663687f * __expf(b1);
        kt[pp * 32 + d] = bflo(kw[i]) * __expf(-b0);
        kt[pp * 32 + d + 1] = bfhi(kw[i]) * __expf(-b1);
      }
      const uint4* vp = (const uint4*)(U + (size_t)tok * NU + UGV + h * 64 + q4 * 16);
      const uint4 v0 = vp[0], v1 = vp[1];
      const unsigned vw[8] = {v0.x, v0.y, v0.z, v0.w, v1.x, v1.y, v1.z, v1.w};
#pragma unroll
      for (int i = 0; i < 8; ++i) { vs[pp * 64 + q4 * 16 + 2 * i] = bflo(vw[i]); vs[pp * 64 + q4 * 16 + 2 * i + 1] = bfhi(vw[i]); }
    }
    __syncthreads();
    {
      const int pp = tid >> 2, sq = tid & 3;
      float qr[32];
#pragma unroll
      for (int d = 0; d < 32; ++d) qr[d] = qt[pp * 32 + d];
#pragma unroll 1
      for (int si = 0; si < 16; ++si) {
        const int s = sq * 16 + si;
        float a = 0.f;
        if (s <= pp) {
#pragma unroll
          for (int d = 0; d < 32; ++d) a += qr[d] * kt[s * 32 + d];
        }
        att[pp * 65 + s] = a;
      }
    }
    __syncthreads();
    {
#pragma unroll 2
      for (int s = 0; s < 64; ++s) {
        const float vv = vs[s * 64 + e];
#pragma unroll
        for (int i = 0; i < 16; ++i) { const int tau = pq * 16 + i, pp = dir ? 63 - tau : tau; oacc[i] += att[pp * 65 + s] * vv; }
      }
#pragma unroll 2
      for (int d = 0; d < 32; ++d) {
        const float sv = Sp[d * 64 + e];
#pragma unroll
        for (int i = 0; i < 16; ++i) { const int tau = pq * 16 + i, pp = dir ? 63 - tau : tau; oacc[i] += qt[pp * 32 + d] * sv; }
      }
    }
    __syncthreads();
  }
  {
    bf16_t* YS = (bf16_t*)(PWS + OFF_YS);
    const float gnorm = P.in[I_GNORM][l * 256 + h * 64 + e];
#pragma unroll
    for (int i = 0; i < 16; ++i) {
      const size_t tok = (size_t)(c0 + pq * 16 + i);
      const float og = oacc[i];
      const float ms = wave_sum(og * og) * (1.f / 64.f);
      const float go = bf2f(U[tok * NU + UGO + h * 64 + e]);
      YS[tok * 1024 + 768 + h * 64 + e] = f2bf(og * rsqrtf(ms + 1e-6f) * gnorm * (go * sigmoidf_(go)));
    }
  }
}

#define SC_BUF 22528
__device__ __forceinline__ void rwkv_scan(const Params& P, int l, int item, bool dry, unsigned char* smem) {
  const int tid = otid();
  int seq, sub;
  if (item < 64) { seq = 16 + (item >> 5); sub = item & 31; } else { seq = (item - 64) >> 5; sub = (item - 64) & 31; }
  const int h = sub >> 3, dir = (sub >> 2) & 1, rg = sub & 3;
  const int start = seq < 16 ? seq * 256 : 4096 + (seq - 16) * 4096, L = seq < 16 ? 256 : 4096;
  const int rowl = tid >> 4, j = tid & 15, row = rg * 16 + rowl;
  unsigned char* ws = PWS;
  const float* Wd = (const float*)(ws + OFF_M + M_W) + (size_t)dir * NT * 256 + h * 64 + j * 4;
  const bf16_t* KD = (const bf16_t*)(ws + OFF_M + M_KD) + (size_t)dir * NT * 256 + h * 64 + j * 4;
  const bf16_t* Bb = (const bf16_t*)(ws + OFF_M + M_B) + (size_t)dir * NT * 256 + h * 64 + j * 4;
  const bf16_t* Rr = (const bf16_t*)(ws + OFF_M + M_R) + h * 64 + j * 4;
  const bf16_t* KKn = (const bf16_t*)(ws + OFF_M + M_KK) + h * 64 + j * 4;
  const bf16_t* Vv = (const bf16_t*)(ws + OFF_M + M_V) + h * 64 + rg * 16 + j;
  float* ORW = (float*)(ws + OFF_ORW) + h * 64 + rg * 16 + j;
  typedef float f32x2 __attribute__((ext_vector_type(2)));
  f32x2 S01, S23;
  if (seq < 16) {
    S01 = (f32x2){0.f, 0.f}; S23 = (f32x2){0.f, 0.f};
  } else {
    const f32x4 s0 = *(const f32x4*)(P.in[I_SRW] + (((((size_t)(seq - 16) * 2 + l) * 2 + dir) * 4 + h) * 64 + row) * 64 + j * 4);
    S01 = (f32x2){s0[0], s0[1]}; S23 = (f32x2){s0[2], s0[3]};
  }
  f32x4 gw; uint2 gkd, gb, gkk, gr; unsigned gv;
  const int nch = L >> 4;
#define SC_TOK(c_) ((size_t)(start + (dir ? L - 1 - ((c_) * 16 + rowl) : (c_) * 16 + rowl)))
#define SC_LOAD(c_) { const size_t tk = SC_TOK(c_) * 256; gw = *(const f32x4*)(Wd + tk); gkd = *(const uint2*)(KD + tk); gb = *(const uint2*)(Bb + tk); \
    gkk = *(const uint2*)(KKn + tk); gr = *(const uint2*)(Rr + tk); gv = Vv[tk]; }
#define SC_STORE(b_) { float* base = (float*)(smem + (b_) * SC_BUF) + rowl * 64 + j * 4; \
    *(f32x4*)(base) = gw; \
    *(f32x4*)(base + 1024) = (f32x4){bflo(gkd.x), bfhi(gkd.x), bflo(gkd.y), bfhi(gkd.y)}; \
    *(f32x4*)(base + 2048) = (f32x4){bflo(gb.x), bfhi(gb.x), bflo(gb.y), bfhi(gb.y)}; \
    *(f32x4*)(base + 3072) = (f32x4){bflo(gkk.x), bfhi(gkk.x), bflo(gkk.y), bfhi(gkk.y)}; \
    *(f32x4*)(base + 4096) = (f32x4){bflo(gr.x), bfhi(gr.x), bflo(gr.y), bfhi(gr.y)}; \
    ((float*)(smem + (b_) * SC_BUF + 20480))[j * 16 + rowl] = __uint_as_float(gv << 16); }
  SC_LOAD(0)
  SC_STORE(0)
  if (nch > 1) SC_LOAD(1)
  __syncthreads();
#pragma unroll 1
  for (int c = 0; c < nch; ++c) {
    const float* buf = (const float*)(smem + (c & 1) * SC_BUF);
    float* outl = (float*)(smem + (c & 1) * SC_BUF + 21504);
    float myout = 0.f;
    f32x4 v4[4];
#pragma unroll
    for (int i = 0; i < 4; ++i) v4[i] = *(const f32x4*)(buf + 5120 + rowl * 16 + i * 4);
    f32x4 w4 = *(const f32x4*)(buf + j * 4), kd4 = *(const f32x4*)(buf + 1024 + j * 4), b4 = *(const f32x4*)(buf + 2048 + j * 4),
          kk4 = *(const f32x4*)(buf + 3072 + j * 4), r4 = *(const f32x4*)(buf + 4096 + j * 4);
    float dot;
    {
      f32x2 p = S01 * (f32x2){kk4[0], kk4[1]};
      p = S23 * (f32x2){kk4[2], kk4[3]} + p;
      dot = row16_sum(p[0] + p[1]);
    }
#pragma unroll
    for (int s = 0; s < 16; ++s) {
      f32x4 w4n, kd4n, b4n, kk4n, r4n;
      if (s < 15) {
        w4n = *(const f32x4*)(buf + (s + 1) * 64 + j * 4);
        kd4n = *(const f32x4*)(buf + 1024 + (s + 1) * 64 + j * 4);
        b4n = *(const f32x4*)(buf + 2048 + (s + 1) * 64 + j * 4);
        kk4n = *(const f32x4*)(buf + 3072 + (s + 1) * 64 + j * 4);
        r4n = *(const f32x4*)(buf + 4096 + (s + 1) * 64 + j * 4);
      }
      __builtin_amdgcn_sched_barrier(0);
      const float vf = v4[s >> 2][s & 3];
      const f32x2 t01 = S01 * (f32x2){w4[0], w4[1]} + (f32x2){kd4[0], kd4[1]} * vf;
      const f32x2 t23 = S23 * (f32x2){w4[2], w4[3]} + (f32x2){kd4[2], kd4[3]} * vf;
      S01 = t01 - (f32x2){b4[0], b4[1]} * dot;
      S23 = t23 - (f32x2){b4[2], b4[3]} * dot;
      f32x2 o = S01 * (f32x2){r4[0], r4[1]};
      o = S23 * (f32x2){r4[2], r4[3]} + o;
      float od = o[0] + o[1];
      if (s < 15) {
        f32x2 p = S01 * (f32x2){kk4n[0], kk4n[1]};
        p = S23 * (f32x2){kk4n[2], kk4n[3]} + p;
        float dn = p[0] + p[1];
        row16_sum2(dn, od);
        dot = dn;
        w4 = w4n; kd4 = kd4n; b4 = b4n; kk4 = kk4n; r4 = r4n;
      } else {
        od = row16_sum(od);
      }
      myout = (j == s) ? od : myout;
    }
    outl[j * 16 + rowl] = myout;
    if (c + 1 < nch) SC_STORE((c + 1) & 1)
    __syncthreads();
    if (!dry) __hip_atomic_fetch_add(ORW + SC_TOK(c) * 256, outl[rowl * 16 + j], __ATOMIC_RELAXED, __HIP_MEMORY_SCOPE_AGENT);
    if (c + 2 < nch) SC_LOAD(c + 2)
  }
#undef SC_TOK
#undef SC_LOAD
#undef SC_STORE
  if (seq < 16 && !dry) {
    f32x4 o; o[0] = S01[0]; o[1] = S01[1]; o[2] = S23[0]; o[3] = S23[1];
    *(f32x4*)(P.out + OUT_SR + (((((size_t)seq * 2 + l) * 2 + dir) * 4 + h) * 64 + row) * 64 + j * 4) = o;
  }
  __syncthreads();
}

__device__ __forceinline__ void fourier_tile(const Params& P, int item, unsigned char* smem) {
  int seq, mt, nt;
  if (item < 128) { seq = 16 + (item >> 6); mt = (item >> 1) & 31; nt = item & 1; }
  else { const int r = item - 128; seq = r >> 2; mt = (r >> 1) & 1; nt = r & 1; }
  const int start = seq < 16 ? seq * 256 : 4096 + (seq - 16) * 4096, L = seq < 16 ? 256 : 4096, sh = seq < 16 ? 4 : 0;
  const bf16_t* ZT = (const bf16_t*)(PWS + OFF_ZT);
  bf16_t* YS = (bf16_t*)(PWS + OFF_YS);
  f32x4 acc[4][4]; ACC_ZERO(acc);
  if (seq < 16) {
    gemm_acc<1, 4, 4>(acc, nullptr, 0, ZT + (size_t)(nt * 128) * NT + start, NT, smem, mt * 128, 255, 4, 0, 0);
    gemm_acc<1, 4, 4>(acc, nullptr, 0, ZT + (size_t)(256 + nt * 128) * NT + start, NT, smem, mt * 128, 255, 4, 3072, 0);
  } else {
#pragma unroll 1
    for (int pass = 0; pass < 8; ++pass) {
      const int nb = (pass & 3) * 1024, sn = pass >> 2;
      gemm_acc<1, 4, 16>(acc, nullptr, 0, ZT + (size_t)(sn * 256 + nt * 128) * NT + start + nb, NT, smem, mt * 128, 4095, 0, sn ? 3072 : 0, nb);
    }
  }
  const float scl = seq < 16 ? 0.0625f : 0.015625f;
  EPI_BEGIN(acc)
    uint4 pk; pk.x = pk2(v0[0] * scl, v0[1] * scl); pk.y = pk2(v0[2] * scl, v0[3] * scl); pk.z = pk2(v1[0] * scl, v1[1] * scl); pk.w = pk2(v1[2] * scl, v1[3] * scl);
    *(uint4*)(YS + (size_t)(start + mt * 128 + r) * 1024 + 256 + nt * 128 + c) = pk;
  EPI_END
}

#define CT 24
__device__ __forceinline__ void gatec_tile(const Params& P, int l, int tile, unsigned char* smem) {
  const int tid = otid(), tok0 = tile * CT, col = tid;
  const bf16_t* U = (const bf16_t*)(PWS + OFF_U);
  bf16_t* YS = (bf16_t*)(PWS + OFF_YS);
  float* sg = (float*)smem;
  for (int i = tid; i < CT * 64; i += 256) sg[i] = sigmoidf_(bf2f(U[(size_t)(tok0 + (i >> 6)) * NU + UCG + (i & 63)]));
  __syncthreads();
  float gate[CT];
  {
    float wreg[64];
    const float* bg = P.in[I_BG] + (size_t)l * 64 * 256 + col;
#pragma unroll
    for (int r = 0; r < 64; ++r) wreg[r] = bg[r * 256];
#pragma unroll
    for (int tt = 0; tt < CT; ++tt) {
      float a0 = 0.f, a1 = 0.f;
#pragma unroll
      for (int r4 = 0; r4 < 16; ++r4) {
        const f32x4 x4 = *(const f32x4*)(sg + tt * 64 + r4 * 4);
        a0 += x4[0] * wreg[r4 * 4] + x4[2] * wreg[r4 * 4 + 2];
        a1 += x4[1] * wreg[r4 * 4 + 1] + x4[3] * wreg[r4 * 4 + 3];
      }
      gate[tt] = a0 + a1;
    }
  }
  bf16_t* GC = (bf16_t*)(PWS + OFF_M + M_OG);
  const bf16_t* Rr_ = (const bf16_t*)(PWS + OFF_M + M_R);
  const bf16_t* Vv_ = (const bf16_t*)(PWS + OFF_M + M_V);
  const bf16_t* KD_ = (const bf16_t*)(PWS + OFF_M + M_KD);
  const float rk_ = P.in[I_RK][l * 256 + col];
#pragma unroll
  for (int tt = 0; tt < CT; ++tt) {
    const size_t o = (size_t)(tok0 + tt) * 256 + col;
    const float r = bf2f(Rr_[o]), v = bf2f(Vv_[o]);
    const float kds = bf2f(KD_[o]) + bf2f(KD_[(size_t)NT * 256 + o]);
    const float bonus = wave_sum(r * kds * rk_);
    GC[o] = f2bf(gate[tt]);
    GC[(size_t)NT * 256 + o] = f2bf(bonus * v * gate[tt]);
  }
  __syncthreads();
}
__device__ __forceinline__ void combine_tile(const Params& P, int l, int tile, unsigned char* smem) {
  const int tid = otid(), tok0 = tile * CT, col = tid;
  bf16_t* YS = (bf16_t*)(PWS + OFF_YS);
  const bf16_t* GC = (const bf16_t*)(PWS + OFF_M + M_OG);
  const bf16_t* Rr = (const bf16_t*)(PWS + OFF_M + M_R);
  const bf16_t* Vv = (const bf16_t*)(PWS + OFF_M + M_V);
  const bf16_t* KD = (const bf16_t*)(PWS + OFF_M + M_KD);
  const float* ORW = (const float*)(PWS + OFF_ORW);
  const float gn = P.in[I_GN][l * 256 + col], rk = P.in[I_RK][l * 256 + col];
#pragma unroll
  for (int tt = 0; tt < CT; ++tt) {
    const size_t o = (size_t)(tok0 + tt) * 256 + col;
    const float ov = ORW[o];
    const float mu = wave_sum(ov) * (1.f / 64.f);
    const float dv = ov - mu;
    const float var = wave_sum(dv * dv) * (1.f / 64.f);
    const float on = dv * rsqrtf(var + 64e-5f) * gn;
    const float yc = on * bf2f(GC[o]) + bf2f(GC[(size_t)NT * 256 + o]);
    YS[(size_t)(tok0 + tt) * 1024 + 512 + col] = f2bf(yc);
  }
  __syncthreads();
}


#define OFF_BAR WS_END
#define XB_TMO      128
#define XB_XCNT(j)  (256  + 64 * (j))
#define XB_XSUB(j)  (1280 + 64 * (j))
#define XB_XGEN(j)  (2304 + 64 * (j))
#define XB_TOP      3328
#define XB_TOPGEN   3392
#define XCD_BAR_WORDS 3456
#define XB_SPIN_CAP (1u << 18)
#define LAS __attribute__((address_space(3)))

__device__ __forceinline__ unsigned xb_ld(unsigned* p)              { return __hip_atomic_load(p, __ATOMIC_RELAXED, __HIP_MEMORY_SCOPE_AGENT); }
__device__ __forceinline__ unsigned xb_add(unsigned* p, unsigned v) { return __hip_atomic_fetch_add(p, v, __ATOMIC_RELAXED, __HIP_MEMORY_SCOPE_AGENT); }
__device__ __forceinline__ unsigned xb_xcc_id() { return (unsigned)__builtin_amdgcn_s_getreg((3 << 11) | 20) & 0xFu; }
#define XB_SPIN(cond, bar) do { unsigned _sp = 0; while (cond) { __builtin_amdgcn_s_sleep(1); \
    if ((++_sp & 255u) == 0u) { if (xb_ld(&(bar)[XB_TMO])) break; if (_sp > XB_SPIN_CAP) { atomicAdd(&(bar)[XB_TMO], 1u); break; } } } } while (0)

struct XcdBarrier {
    unsigned* bar; unsigned x;
    volatile LAS unsigned* st;
};

__device__ __forceinline__ XcdBarrier xcd_barrier_post(unsigned* bar, volatile LAS unsigned* st) {
    XcdBarrier b; b.bar = bar; b.x = xb_xcc_id(); b.st = st;
    if (otid() == 0) st[2] = xb_add(&bar[XB_XCNT(b.x)], 1u);
    return b;
}
__device__ __forceinline__ void xcd_barrier_complete(unsigned* bar, unsigned x, unsigned& nloc, unsigned& nx) {
    const unsigned G = gridDim.x * gridDim.y * gridDim.z;
    unsigned sum, cnt, mine, sp = 0u;
    for (;;) {
        sum = 0u; cnt = 0u; mine = 0u;
#pragma unroll
        for (unsigned j = 0; j < 16; ++j) { const unsigned c = xb_ld(&bar[XB_XCNT(j)]); sum += c; cnt += (c > 0u) ? 1u : 0u; mine = (j == x) ? c : mine; }
        if (sum == G) break;
        __builtin_amdgcn_s_sleep(1);
        if ((++sp & 255u) == 0u) { if (xb_ld(&bar[XB_TMO])) break; if (sp > XB_SPIN_CAP) { atomicAdd(&bar[XB_TMO], 1u); break; } }
    }
    nloc = mine > 0u ? mine : 1u; nx = cnt > 0u ? cnt : 1u;
}

__device__ __forceinline__ void xcd_barrier(const XcdBarrier& b) {
    asm volatile("s_waitcnt vmcnt(0)" ::: "memory");
    __syncthreads();
    if (otid() == 0) {
        unsigned* bar = b.bar;
        __builtin_amdgcn_s_waitcnt(0);
        unsigned nloc = b.st[0], nx = b.st[1];
        if (nloc == 0u) { xcd_barrier_complete(bar, b.x, nloc, nx); b.st[0] = nloc; b.st[1] = nx; }
        const unsigned old = xb_add(&bar[XB_XSUB(b.x)], 1u);
        const unsigned gen = old / nloc;
        if (old + 1u == (gen + 1u) * nloc) {
            __builtin_amdgcn_fence(__ATOMIC_RELEASE, "agent");
            asm volatile("s_waitcnt vmcnt(0)" ::: "memory");
            const unsigned og = xb_add(&bar[XB_TOP], 1u);
            const unsigned tg = og / nx;
            if (og + 1u == (tg + 1u) * nx) xb_add(&bar[XB_TOPGEN], 1u);
            else XB_SPIN(xb_ld(&bar[XB_TOPGEN]) == tg, bar);
            __builtin_amdgcn_fence(__ATOMIC_ACQUIRE, "agent");
            xb_add(&bar[XB_XGEN(b.x)], 1u);
            asm volatile("s_waitcnt vmcnt(0)" ::: "memory");
        } else {
            XB_SPIN(xb_ld(&bar[XB_XGEN(b.x)]) == gen, bar);
            __builtin_amdgcn_fence(__ATOMIC_ACQUIRE, "agent");
            asm volatile("s_waitcnt vmcnt(0)" ::: "memory");
        }
    }
    __syncthreads();
}
#define gsync(P_, e_) xcd_barrier(xb)

#ifndef R_P0
#define R_P0 1
#endif
#ifndef R_NORM
#define R_NORM 1
#endif
#ifndef R_GEMM
#define R_GEMM 1
#endif
#ifndef R_PREP
#define R_PREP 1
#endif
#ifndef R_SCAN
#define R_SCAN 1
#endif
#ifndef R_FOUR
#define R_FOUR 1
#endif
#ifndef R_G2
#define R_G2 1
#endif
#define REP(n) for (int rep = 0; rep < 1; ++rep)
__global__ void __launch_bounds__(256, 2) mega(Params P) {
  extern __shared__ __attribute__((aligned(16))) unsigned char smem[];
  cg::grid_group grid = cg::this_grid();
  const int G = gridDim.x;
  unsigned epoch = 0;
  int zero = 0; asm volatile("" : "+s"(zero));
  volatile LAS unsigned* xst = (volatile LAS unsigned*)(LAS unsigned char*)(smem + LDS_BYTES - 16);
  if (otid() == 0) { xst[0] = 0u; xst[1] = 0u; }
  __syncthreads();
  XcdBarrier xb = xcd_barrier_post((unsigned*)(PWS + OFF_BAR), xst);
  grid.sync();
  REP(R_P0) {
    phase_mod(P, smem);
    __syncthreads();
    phase_table(P);
    {
      const int nb = G > 256 ? G - 192 : G;
      if (G > 256) { if ((int)blockIdx.x >= 192) phase_convert(P, 0, smem, blockIdx.x - 192, nb); }
      else phase_convert(P, 0, smem, blockIdx.x, nb);
    }
  }
  gsync(P, epoch);
  TL tl;
  {
    const unsigned nloc = xst[0], nx = xst[1], jl = xst[2];
    if (nx == 8u && xb.x < 8u && nloc > 0u) { tl.x = (int)xb.x; tl.j = (int)jl; tl.n = (int)nloc; }
    else { tl.x = blockIdx.x & 7; tl.j = blockIdx.x >> 3; tl.n = G >> 3; }
  }
#pragma unroll 1
  for (int l = 0; l < 2; ++l) {
    REP(R_NORM) {
      if (l == 1) phase_convert(P, 1, smem, blockIdx.x, G);
      phase_norm(P, l, 0);
    }
    gsync(P, epoch);
    REP(R_GEMM) phase_gemm1(P, smem, tl);
#ifdef DUP_GEMM
    phase_gemm1(P, smem, tl);
#endif
    gsync(P, epoch);
    if (G > 384 + 64) {
      if ((int)blockIdx.x < 384) prep_tile(P, l, blockIdx.x, smem);
      else for (int it = blockIdx.x - 384; it < 1536; it += G - 384) gla_g1(P, l, it, smem);
    } else {
      for (int it = blockIdx.x; it < 384 + 1536; it += G) {
        if (it < 384) prep_tile(P, l, it, smem); else gla_g1(P, l, it - 384, smem);
      }
    }
#ifdef DUP_PREP
    for (int it = blockIdx.x; it < 384; it += G) prep_tile(P, l, it, smem);
#endif
#ifdef DUP_G1
    for (int it = blockIdx.x + 384; it < 384 + 1536; it += G) gla_g1(P, l, it - 384, smem);
#endif
    gsync(P, epoch);
    {
      const bf16_t* tabg = (const bf16_t*)(PWS + OFF_TAB);
      bf16_t* tabl = (bf16_t*)(smem + LDS_TAB);
      for (int i = otid(); i < 4096; i += 256) tabl[i] = tabg[i];
      __syncthreads();
      if (G >= 256) {
        const int b = blockIdx.x;
        const bool is_scan = b < 128 && (b & 8) == 0;
        if (is_scan) rwkv_scan(P, l, (b >> 4) * 8 + (b & 7), false, smem);
        else {
          const int ob = b < 128 ? (b >> 4) * 8 + (b & 7) : b - 64;
          for (int it = 64 + ob; it < 576 + 192 + 768 + 384 + NT / CT; it += G - 64) {
            if (it < 576) rwkv_scan(P, l, it, false, smem);
            else if (it < 768) fourier_tile(P, it - 576, smem);
            else if (it < 1536) gla_g2(P, l, it - 768, smem);
            else if (it < 1920) pool_tile(P, l, it - 1536, smem);
            else gatec_tile(P, l, it - 1920, smem);
          }
        }
      } else {
        for (int it = blockIdx.x; it < 576 + 192 + 768 + 384 + NT / CT; it += G) {
          if (it < 576) rwkv_scan(P, l, it, false, smem);
          else if (it < 768) fourier_tile(P, it - 576, smem);
          else if (it < 1536) gla_g2(P, l, it - 768, smem);
          else if (it < 1920) pool_tile(P, l, it - 1536, smem);
          else gatec_tile(P, l, it - 1920, smem);
        }
      }
    }
    gsync(P, epoch);
    REP(R_PREP) for (int it = blockIdx.x; it < NT / CT; it += G) combine_tile(P, l, it, smem);
#ifdef DUP_COMB
    for (int it = blockIdx.x; it < 384; it += G) combine_tile(P, l, it, smem);
#endif
    gsync(P, epoch);
    REP(R_GEMM) phase_gemm_mlog(P, smem, tl);
#ifdef DUP_GEMM
    phase_gemm_mlog(P, smem, tl);
#endif
    gsync(P, epoch);
    REP(R_GEMM) phase_merge(P, smem, tl);
#ifdef DUP_GEMM
    phase_merge(P, smem, tl);
#endif
    gsync(P, epoch);
    REP(R_GEMM) phase_gemm_res(P, l, 0, smem, rep > 0, tl);
    gsync(P, epoch);
    REP(R_NORM) phase_norm(P, l, 1);
    gsync(P, epoch);
    REP(R_GEMM) phase_mlp_up(P, smem, tl);
#ifdef DUP_GEMM
    phase_mlp_up(P, smem, tl);
#endif
    gsync(P, epoch);
    REP(R_GEMM) phase_gemm_res(P, l, 1, smem, rep > 0, tl);
    gsync(P, epoch);
  }
#ifdef R_SYNC
  for (int i = 0; i < R_SYNC + zero; ++i) gsync(P, epoch);
#endif
  phase_norm(P, 0, 2);
}

extern "C" void kernel_launch(void* const* d_in, const int* in_sizes, int n_in, void* d_out, int out_size, void* d_ws, size_t ws_size,
                              hipStream_t stream) {
  static int grid_blocks = 0;
  if (!grid_blocks) {
    int dev = 0, cus = 0, per_cu = 0;
    hipGetDevice(&dev);
    hipDeviceGetAttribute(&cus, hipDeviceAttributeMultiprocessorCount, dev);
    hipFuncSetAttribute((const void*)mega, hipFuncAttributeMaxDynamicSharedMemorySize, LDS_BYTES);
    hipOccupancyMaxActiveBlocksPerMultiprocessor(&per_cu, (const void*)mega, 256, LDS_BYTES);
    per_cu = 2;
    grid_blocks = cus * per_cu;
    if (ws_size < WS_END) fprintf(stderr, "kernel_launch: workspace too small: %zu < %llu\n", ws_size, (unsigned long long)WS_END);
  }
  Params p{};
  for (int i = 0; i < 31; ++i) p.in[i] = (const float*)d_in[i];
  p.out = (float*)d_out;
  p.ws_ = (unsigned char*)d_ws;
  hipMemsetAsync((unsigned char*)d_ws + OFF_BAR, 0, XCD_BAR_WORDS * 4, stream);
  void* args[] = {&p};
  hipError_t e = hipLaunchCooperativeKernel((const void*)mega, dim3(grid_blocks), dim3(256), args, LDS_BYTES, stream);
  if (e != hipSuccess) fprintf(stderr, "cooperative launch failed: %s (grid %d)\n", hipGetErrorString(e), grid_blocks);
}
```
